# Optimizing an MI355X kernel written in HIP

```python
import jax, jax.numpy as jnp
from jax import lax
import numpy as np

D_MODEL = 1024
BATCH = 16
SEQ = 2048
DEPTH = 1

CHUNK = 64
MIX_WIDTH = D_MODEL
HEAD_DIM = 64
SB_WIDTH = MIX_WIDTH // 2
SB_HEADS = SB_WIDTH // HEAD_DIM
RW_WIDTH = MIX_WIDTH - SB_WIDTH
RW_HEADS = RW_WIDTH // HEAD_DIM
DECAY_LORA = 32
AAA_LORA = 32
GATE_LORA = 96
Q_BLOCK = 128
SB_COLS = 3 * SB_WIDTH
RW_COLS = 3 * RW_WIDTH + DECAY_LORA + AAA_LORA + GATE_LORA
IN_COLS = SB_COLS + RW_COLS
N_GROUPS = 4
EXPERTS_PER_GROUP = 8
N_EXPERTS = N_GROUPS * EXPERTS_PER_GROUP
TOP_K = 2
D_EXPERT = 512
EXPERT_BLOCK = 128
NORM_EPS = 1e-6
LN_X_EPS = 64e-5

kernel_name = 'hybrid_stickbreak_rwkv7_hmoe_block'


def rms_norm(x, gain):
    xf = x.astype(jnp.float32)
    y = xf * lax.rsqrt(jnp.mean(xf * xf, axis=-1, keepdims=True) + NORM_EPS)
    return (y * gain.astype(jnp.float32)).astype(x.dtype)


def stick_breaking_attention(q, k, v):
    S, d = q.shape[2], q.shape[3]
    scale = d ** -0.5
    outs = []
    for blk in range(S // Q_BLOCK):
        t0 = blk * Q_BLOCK
        end = t0 + Q_BLOCK
        z = jnp.einsum('bhtd,bhsd->bhts', q[:, :, t0:end], k[:, :, :end]).astype(jnp.float32) * scale
        t_idx = t0 + jnp.arange(Q_BLOCK)[:, None]
        s_idx = jnp.arange(end)[None, :]
        causal = s_idx < t_idx
        log_keep = jnp.where(causal, jax.nn.log_sigmoid(-z), 0.0)
        suffix = lax.cumsum(log_keep, axis=3, reverse=True)
        after = jnp.concatenate([suffix[..., 1:], jnp.zeros_like(suffix[..., :1])], axis=-1)
        weights = jnp.where(causal, jnp.exp(jax.nn.log_sigmoid(z) + after), 0.0)
        outs.append(jnp.einsum('bhts,bhsd->bhtd', weights.astype(v.dtype), v[:, :, :end]))
    return jnp.concatenate(outs, axis=2)


def token_shift(p, mu):
    prev = jnp.pad(p, ((0, 0), (1, 0), (0, 0)))[:, :-1]
    return p + (prev - p) * mu


def rwkv7_time_mix(p, mu, w0, w_up, a0, a_up, g_up, k_k, k_a, r_k, ln_w, ln_b):
    B, S, _ = p.shape
    f32 = jnp.float32
    pf = token_shift(p.astype(f32), mu.astype(f32))
    c = RW_WIDTH
    r = pf[..., :c]
    k = pf[..., c:2 * c]
    v = pf[..., 2 * c:3 * c]
    wd = pf[..., 3 * c:3 * c + DECAY_LORA]
    ad = pf[..., 3 * c + DECAY_LORA:3 * c + DECAY_LORA + AAA_LORA]
    gd = pf[..., 3 * c + DECAY_LORA + AAA_LORA:]
    w = -jax.nn.softplus(-(w0.astype(f32) + jnp.tanh(wd) @ w_up.astype(f32))) - 0.5
    decay = jnp.exp(-jnp.exp(w))
    a = jax.nn.sigmoid(a0.astype(f32) + ad @ a_up.astype(f32))
    g = jax.nn.sigmoid(gd) @ g_up.astype(f32)
    heads = lambda t: t.reshape(B, S, RW_HEADS, HEAD_DIM)
    r, k, v, decay, a = heads(r), heads(k), heads(v), heads(decay), heads(a)
    kk = k * k_k.astype(f32).reshape(RW_HEADS, HEAD_DIM)
    kk = kk / jnp.maximum(jnp.sqrt(jnp.sum(kk * kk, axis=-1, keepdims=True)), 1e-12)
    k = k * (1.0 + (a - 1.0) * k_a.astype(f32).reshape(RW_HEADS, HEAD_DIM))
    xs = tuple(jnp.moveaxis(t, 1, 0) for t in (r, decay, k, v, -kk, kk * a))

    def step(state, inp):
        r_t, w_t, k_t, v_t, a_t, b_t = inp
        sa = jnp.einsum('bhvk,bhk->bhv', state, a_t)
        state = (state * w_t[:, :, None, :] + sa[..., None] * b_t[:, :, None, :]
                 + v_t[..., None] * k_t[:, :, None, :])
        return state, jnp.einsum('bhvk,bhk->bhv', state, r_t)

    state0 = jnp.zeros((B, RW_HEADS, HEAD_DIM, HEAD_DIM), f32)
    _, y = lax.scan(step, state0, xs)
    y = jnp.moveaxis(y, 0, 1)
    mean = jnp.mean(y, axis=-1, keepdims=True)
    var = jnp.mean(jnp.square(y - mean), axis=-1, keepdims=True)
    yn = ((y - mean) * lax.rsqrt(var + LN_X_EPS) * ln_w.astype(f32).reshape(RW_HEADS, HEAD_DIM)
          + ln_b.astype(f32).reshape(RW_HEADS, HEAD_DIM))
    bonus = jnp.sum(r * k * r_k.astype(f32), axis=-1, keepdims=True) * v
    out = (yn + bonus).reshape(B, S, c) * g
    return out.astype(p.dtype)


def hierarchical_moe(h, w_rg, w_re, w_g, w_u, w_d):
    B, S, D = h.shape
    hf = h.reshape(-1, D)
    n_tok = B * S
    group_logits = (hf @ w_rg).astype(jnp.float32)
    group_prob = jax.nn.softmax(group_logits, axis=-1)
    group_idx = jnp.argmax(group_logits, axis=-1).astype(jnp.int32)
    group_gate = jnp.take_along_axis(group_prob, group_idx[:, None], axis=-1)
    exp_logits = (hf @ w_re).astype(jnp.float32).reshape(n_tok, N_GROUPS, EXPERTS_PER_GROUP)
    in_group = jnp.take_along_axis(exp_logits, group_idx[:, None, None], axis=1)[:, 0]
    top_p, top_i = lax.top_k(jax.nn.softmax(in_group, axis=-1), TOP_K)
    gates = group_gate * top_p / jnp.sum(top_p, axis=-1, keepdims=True)
    eid = (group_idx[:, None] * EXPERTS_PER_GROUP + top_i.astype(jnp.int32)).reshape(-1)
    n_slot = n_tok * TOP_K
    order = jnp.argsort(eid).astype(jnp.int32)
    sorted_eid = eid[order]
    counts = jnp.zeros((N_EXPERTS,), jnp.int32).at[eid].add(1)
    padded = (counts + EXPERT_BLOCK - 1) // EXPERT_BLOCK * EXPERT_BLOCK
    pad_end = jnp.cumsum(padded).astype(jnp.int32)
    pad_start = pad_end - padded
    start = jnp.cumsum(counts).astype(jnp.int32) - counts
    dest_sorted = pad_start[sorted_eid] + jnp.arange(n_slot, dtype=jnp.int32) - start[sorted_eid]
    slot_dest = jnp.zeros((n_slot,), jnp.int32).at[order].set(dest_sorted)
    n_rows = (n_slot + EXPERT_BLOCK - 1) // EXPERT_BLOCK * EXPERT_BLOCK + N_EXPERTS * EXPERT_BLOCK
    n_blocks = n_rows // EXPERT_BLOCK
    token_of_slot = jnp.arange(n_slot, dtype=jnp.int32) // TOP_K
    buf = jnp.zeros((n_rows, D), h.dtype).at[slot_dest].set(hf[token_of_slot])
    block_start = jnp.arange(n_blocks, dtype=jnp.int32) * EXPERT_BLOCK
    block_eid = jnp.minimum(jnp.sum((pad_end[None, :] <= block_start[:, None]).astype(jnp.int32), axis=1),
                            N_EXPERTS - 1)

    def expert_block(args):
        xb, e = args
        return (jax.nn.silu(xb @ w_g[e]) * (xb @ w_u[e])) @ w_d[e]

    out = lax.map(expert_block, (buf.reshape(n_blocks, EXPERT_BLOCK, D), block_eid)).reshape(n_rows, D)
    y = jnp.sum(out[slot_dest].reshape(n_tok, TOP_K, D) * gates[..., None].astype(h.dtype), axis=1)
    return y.reshape(B, S, D)


def setup_inputs(seed: int = 0) -> dict:
    key = jax.random.key(seed)
    ks = jax.random.split(key, 24)
    L = DEPTH
    f32 = jnp.float32
    nrm = lambda k, shape: jax.random.normal(k, shape, f32)
    lin = lambda k, shape, fan_in: nrm(k, shape) * fan_in ** -0.5
    return {
        'x': nrm(ks[0], (BATCH, SEQ, D_MODEL)),
        'norm1_gain': 1.0 + 0.1 * nrm(ks[1], (L, D_MODEL)),
        'w_in': lin(ks[2], (L, D_MODEL, IN_COLS), D_MODEL),
        'sb_q_gain': 1.0 + 0.1 * nrm(ks[3], (L, HEAD_DIM)),
        'sb_k_gain': 1.0 + 0.1 * nrm(ks[4], (L, HEAD_DIM)),
        'rw_shift_mu': jax.random.uniform(ks[5], (L, RW_COLS), f32),
        'rw_w0': jax.random.uniform(ks[6], (L, RW_WIDTH), f32, minval=-6.5, maxval=-1.5),
        'rw_w_up': 0.1 * lin(ks[7], (L, DECAY_LORA, RW_WIDTH), DECAY_LORA),
        'rw_a0': 0.1 * nrm(ks[8], (L, RW_WIDTH)),
        'rw_a_up': lin(ks[9], (L, AAA_LORA, RW_WIDTH), AAA_LORA),
        'rw_g_up': lin(ks[10], (L, GATE_LORA, RW_WIDTH), GATE_LORA),
        'rw_k_k': 0.85 + 0.05 * nrm(ks[11], (L, RW_WIDTH)),
        'rw_k_a': 1.0 + 0.05 * nrm(ks[12], (L, RW_WIDTH)),
        'rw_r_k': 0.1 * nrm(ks[13], (L, RW_HEADS, HEAD_DIM)),
        'rw_ln_w': 1.0 + 0.1 * nrm(ks[14], (L, RW_WIDTH)),
        'rw_ln_b': 0.02 * nrm(ks[15], (L, RW_WIDTH)),
        'w_out': lin(ks[16], (L, MIX_WIDTH, D_MODEL), MIX_WIDTH),
        'norm2_gain': 1.0 + 0.1 * nrm(ks[17], (L, D_MODEL)),
        'w_router_group': lin(ks[18], (L, D_MODEL, N_GROUPS), D_MODEL),
        'w_router_expert': lin(ks[19], (L, D_MODEL, N_EXPERTS), D_MODEL),
        'w_exp_gate': lin(ks[20], (L, N_EXPERTS, D_MODEL, D_EXPERT), D_MODEL),
        'w_exp_up': lin(ks[21], (L, N_EXPERTS, D_MODEL, D_EXPERT), D_MODEL),
        'w_exp_down': lin(ks[22], (L, N_EXPERTS, D_EXPERT, D_MODEL), D_EXPERT),
    }


def reference(x, norm1_gain, w_in, sb_q_gain, sb_k_gain, rw_shift_mu, rw_w0, rw_w_up, rw_a0,
              rw_a_up, rw_g_up, rw_k_k, rw_k_a, rw_r_k, rw_ln_w, rw_ln_b, w_out, norm2_gain,
              w_router_group, w_router_expert, w_exp_gate, w_exp_up, w_exp_down):
    B, S, _ = x.shape
    for l in range(DEPTH):
        h = rms_norm(x, norm1_gain[l])
        proj = h @ w_in[l]
        sb = proj[..., :SB_COLS]
        q = rms_norm(sb[..., :SB_WIDTH].reshape(B, S, SB_HEADS, HEAD_DIM), sb_q_gain[l]).transpose(0, 2, 1, 3)
        k = rms_norm(sb[..., SB_WIDTH:2 * SB_WIDTH].reshape(B, S, SB_HEADS, HEAD_DIM), sb_k_gain[l]).transpose(0, 2, 1, 3)
        v = sb[..., 2 * SB_WIDTH:].reshape(B, S, SB_HEADS, HEAD_DIM).transpose(0, 2, 1, 3)
        sb_out = stick_breaking_attention(q, k, v).transpose(0, 2, 1, 3).reshape(B, S, SB_WIDTH)
        rw_out = rwkv7_time_mix(proj[..., SB_COLS:], rw_shift_mu[l], rw_w0[l], rw_w_up[l], rw_a0[l],
                                rw_a_up[l], rw_g_up[l], rw_k_k[l], rw_k_a[l], rw_r_k[l],
                                rw_ln_w[l], rw_ln_b[l])
        mix = jnp.concatenate([sb_out, rw_out], axis=-1)
        x = x + mix @ w_out[l]
        h2 = rms_norm(x, norm2_gain[l])
        x = x + hierarchical_moe(h2, w_router_group[l], w_router_expert[l],
                                 w_exp_gate[l], w_exp_up[l], w_exp_down[l])
    return x
```

```cpp
#include <hip/hip_runtime.h>
#include <cstdio>
#include <cstdint>

#ifndef MK_N_LAUNCHES
#define MK_N_LAUNCHES 1
#endif

namespace pg8 {
#define PG8_LAS __attribute__((address_space(3)))
typedef unsigned short bf16_t;
typedef short bf16x8 __attribute__((ext_vector_type(8)));
typedef float f32x4 __attribute__((ext_vector_type(4)));
typedef unsigned u32x4 __attribute__((ext_vector_type(4)));
typedef int v4i_t __attribute__((ext_vector_type(4)));
typedef int v8i_t __attribute__((ext_vector_type(8)));
constexpr int BM = 256, BK = 64, HALF = 128, HTB = HALF * BK * 2  , STAGE_BYTES = 8 * HTB, NXCD = 8, WGM = 8;

__host__ __device__ __forceinline__ int lds_byte(int r, int c) { const int st = (r >> 4) * 2 + (c >> 5), rr = r & 15, cc = c & 31, ob = rr * 64 + cc * 2; return st * 1024 + (ob ^ (((ob >> 9) & 1) << 5)); }
__host__ __device__ __forceinline__ void stage_rc(int b, int& R, int& C) { const int st = b / 1024, sb = b % 1024, swz = sb ^ (((sb >> 9) & 1) << 5); R = (st >> 1) * 16 + swz / 64; C = (st & 1) * 32 + (swz % 64) / 2; }
__host__ __device__ __forceinline__ int perm32(int rho) { const int n = rho >> 4, i = rho & 15; return 8 * (i >> 2) + 4 * n + (i & 3); }

struct Unit { int pm, pn; };
struct Gemm { const bf16_t* A; const bf16_t* Bt; int M, N, K; };

struct StaticOrder {
    int nM, nN, nwg, G, c;
    __host__ __device__ void init(int M, int N, int G_, int c_) { nM = M / BM; nN = N / BM; nwg = nM * nN; G = G_; c = c_; }
    __host__ __device__ bool next(int i, Unit& u) const {
        const long L = (long)i * G + c; if (L >= nwg) return false;
        int wgid = (int)L; { const int q = nwg / NXCD, r = nwg % NXCD, xcd = wgid % NXCD, off = wgid / NXCD; wgid = (xcd < r ? xcd * (q + 1) : r * (q + 1) + (xcd - r) * q) + off; }
        const int nig = WGM * nN, gid = wgid / nig, fm = gid * WGM, gsz = (nM - fm) < WGM ? (nM - fm) : WGM;
        u.pm = fm + ((wgid % nig) % gsz); u.pn = (wgid % nig) / gsz; return true;
    }
    __device__ __forceinline__ unsigned arow(int, int) const { return 0u; }
};
struct MoeOrder {
    const PG8_LAS int* tstart;
    const PG8_LAS unsigned* rowoff;
    int G, c, ntn;
    __device__ __forceinline__ bool next(int i, Unit& u) const {
        const int L = i * G + c, total = tstart[32] * ntn; if (L >= total) return false;
        const int rt = L / ntn, pnl = L - rt * ntn; int e = 0;
#pragma unroll
        for (int j = 1; j < 32; ++j) e += (rt >= tstart[j]) ? 1 : 0;
        u.pm = rt; u.pn = e * ntn + pnl; return true;
    }
    __device__ __forceinline__ unsigned arow(int ui, int r) const { return rowoff[ui * 256 + r]; }
};

__device__ __forceinline__ unsigned pk4_fp8(float a, float b, float c, float d) { int w = 0; w = __builtin_amdgcn_cvt_pk_fp8_f32(a, b, w, false); w = __builtin_amdgcn_cvt_pk_fp8_f32(c, d, w, true); return (unsigned)w; }
__device__ __forceinline__ unsigned cvt_pk_bf16(float lo, float hi) { unsigned r; asm volatile("v_cvt_pk_bf16_f32 %0, %1, %2" : "=v"(r) : "v"(lo), "v"(hi)); return r; }

struct EpiProj {
    static constexpr bool PERM = true, AFTER_DRAIN = false;
    bf16_t* qkv; bf16_t* rw;
    __device__ __forceinline__ void operator()(const f32x4 (&acc)[2][2][4][2], const Unit& u, int wr, int wc, int fr, int fq) const {
        const int row0 = u.pm * BM + wr * 64 + fr; const int colt = u.pn * BM;
        bf16_t* base; int ldc, c0;
        if (colt < 1536) { base = qkv; ldc = 1536; c0 = colt; } else { base = rw; ldc = 1792; c0 = colt - 1536; }
        const int col0 = c0 + wc * 32 + 8 * fq;
#pragma unroll
        for (int ai = 0; ai < 2; ++ai)
#pragma unroll
            for (int m = 0; m < 4; ++m) { const int row = row0 + ai * HALF + m * 16; bf16_t* rowp = base + (size_t)row * ldc + col0;
#pragma unroll
                for (int bj = 0; bj < 2; ++bj) { const f32x4 v0 = acc[ai][bj][m][0], v1 = acc[ai][bj][m][1];
                    u32x4 w; w.x = cvt_pk_bf16(v0[0], v0[1]); w.y = cvt_pk_bf16(v0[2], v0[3]); w.z = cvt_pk_bf16(v1[0], v1[1]); w.w = cvt_pk_bf16(v1[2], v1[3]);
                    *(u32x4*)(rowp + bj * HALF) = w; } }
    }
};
struct EpiRes {
    static constexpr bool PERM = true, AFTER_DRAIN = false;
    bf16_t* xio; float* ssp; const float* inv_rstd;
    __device__ __forceinline__ void operator()(const f32x4 (&acc)[2][2][4][2], const Unit& u, int wr, int wc, int fr, int fq) const {
        const int row0 = u.pm * BM + wr * 64 + fr, col0 = u.pn * BM + wc * 32 + 8 * fq;
#pragma unroll
        for (int ai = 0; ai < 2; ++ai)
#pragma unroll
            for (int m = 0; m < 4; ++m) { const int row = row0 + ai * HALF + m * 16; bf16_t* rowp = xio + (size_t)row * 1024 + col0; float sq = 0.f; const float ir = inv_rstd[row];
#pragma unroll
                for (int bj = 0; bj < 2; ++bj) { const u32x4 rb = *(const u32x4*)(rowp + bj * HALF); float v[8];
#pragma unroll
                    for (int j = 0; j < 4; ++j) { v[2 * j] = __builtin_bit_cast(float, rb[j] << 16) * ir + acc[ai][bj][m][j >> 1][(2 * j) & 3]; v[2 * j + 1] = __builtin_bit_cast(float, rb[j] & 0xffff0000u) * ir + acc[ai][bj][m][j >> 1][(2 * j + 1) & 3]; }
#pragma unroll
                    for (int j = 0; j < 8; ++j) sq += v[j] * v[j];
                    u32x4 w; w.x = cvt_pk_bf16(v[0], v[1]); w.y = cvt_pk_bf16(v[2], v[3]); w.z = cvt_pk_bf16(v[4], v[5]); w.w = cvt_pk_bf16(v[6], v[7]);
                    *(u32x4*)(rowp + bj * HALF) = w; }
                sq += __shfl_xor(sq, 16); sq += __shfl_xor(sq, 32);
                if (fq == 0) ssp[(size_t)row * 16 + u.pn * 4 + wc] = sq; }
    }
};
struct EpiSwiGLU {
    static constexpr bool PERM = true, AFTER_DRAIN = false;
    unsigned char* act; float in_scale, out_scale;
    __device__ __forceinline__ void operator()(const f32x4 (&acc)[2][2][4][2], const Unit& u, int wr, int wc, int fr, int fq) const {
        const int row0 = u.pm * BM + wr * 64 + fr, col0 = (u.pn & 3) * HALF + wc * 32 + 8 * fq;
#pragma unroll
        for (int ai = 0; ai < 2; ++ai)
#pragma unroll
            for (int m = 0; m < 4; ++m) { unsigned char* rowp = act + (size_t)(row0 + ai * HALF + m * 16) * 512 + col0; float o[8];
#pragma unroll
                for (int n = 0; n < 2; ++n)
#pragma unroll
                    for (int j = 0; j < 4; ++j) { const float g = acc[ai][0][m][n][j] * in_scale, uu = acc[ai][1][m][n][j] * in_scale; const float v = g * uu * __builtin_amdgcn_rcpf(1.f + __expf(-g)) * out_scale; o[n * 4 + j] = fminf(fmaxf(v, -416.f), 416.f); }
                *(unsigned long long*)rowp = (unsigned long long)pk4_fp8(o[0], o[1], o[2], o[3]) | ((unsigned long long)pk4_fp8(o[4], o[5], o[6], o[7]) << 32); }
    }
};
struct EpiDown {
    static constexpr bool PERM = true, AFTER_DRAIN = false;
    unsigned char* o; float scale;
    __device__ __forceinline__ void operator()(const f32x4 (&acc)[2][2][4][2], const Unit& u, int wr, int wc, int fr, int fq) const {
        const int row0 = u.pm * BM + wr * 64 + fr, col0 = (u.pn & 3) * BM + wc * 32 + 8 * fq;
#pragma unroll
        for (int ai = 0; ai < 2; ++ai)
#pragma unroll
            for (int m = 0; m < 4; ++m) { unsigned char* rowp = o + (size_t)(row0 + ai * HALF + m * 16) * 1024 + col0;
#pragma unroll
                for (int bj = 0; bj < 2; ++bj) { float v[8];
#pragma unroll
                    for (int j = 0; j < 4; ++j) { v[j] = fminf(fmaxf(acc[ai][bj][m][0][j] * scale, -416.f), 416.f); v[4 + j] = fminf(fmaxf(acc[ai][bj][m][1][j] * scale, -416.f), 416.f); }
                    *(unsigned long long*)(rowp + bj * HALF) = (unsigned long long)pk4_fp8(v[0], v[1], v[2], v[3]) | ((unsigned long long)pk4_fp8(v[4], v[5], v[6], v[7]) << 32); } }
    }
};

template <class Epi, class Sched, bool ALIGN_EPI, bool GATHER, bool F8 = false>
__device__ __forceinline__ void gemm_phase(PG8_LAS unsigned char* lds, const Gemm g, const Sched& S, const Epi& E) {
    int tid_ = threadIdx.x; asm volatile("" : "+v"(tid_));
    const int tid = tid_, wid = __builtin_amdgcn_readfirstlane(tid >> 6), lane = tid & 63, wr = wid >> 2, wc = wid & 3, fr = lane & 15, fq = lane >> 4;
    const int K = g.K, KB = F8 ? K : 2 * K, nt = KB / 128;
    unsigned voffA[2], voffB[2]; int RA[2], CA2[2];
#pragma unroll
    for (int i = 0; i < 2; ++i) { int R, C; stage_rc(tid * 16 + i * 8192, R, C); const int Rb = Epi::PERM ? ((R & ~31) + perm32(R & 31)) : R;
        voffA[i] = (unsigned)(R * KB + C * 2); voffB[i] = (unsigned)(Rb * KB + C * 2); RA[i] = R; CA2[i] = C * 2; }
    const size_t kstep = (size_t)128;
    const size_t hstep = (size_t)HALF * KB;
    const size_t tstep = 2 * hstep;
    const size_t hA = GATHER ? 0 : hstep;
    const unsigned ldsw = (unsigned)wid * 1024u;
    const int aoffk[2] = {F8 ? lds_byte(wr * 64 + fr, fq * 16) : lds_byte(wr * 64 + fr, fq * 8), F8 ? lds_byte(wr * 64 + fr, fq * 16 + 8) : lds_byte(wr * 64 + fr, fq * 8) + 1024};
    const int boffk[2] = {F8 ? lds_byte(wc * 32 + fr, fq * 16) : lds_byte(wc * 32 + fr, fq * 8), F8 ? lds_byte(wc * 32 + fr, fq * 16 + 8) : lds_byte(wc * 32 + fr, fq * 8) + 1024};
#define PG8_SA(b, h) (((b) * 2 + (h)) * HTB)
#define PG8_SB(b, h) ((4 + (b) * 2 + (h)) * HTB)
#define PG8_STAGE(bufoff, gbase, voff) do { _Pragma("unroll") for (int _i = 0; _i < 2; ++_i) \
        __builtin_amdgcn_global_load_lds((const unsigned*)((const char*)(gbase) + (voff)[_i]), (PG8_LAS unsigned*)(lds + (bufoff) + ldsw + _i * 8192), 16, 0, 0); } while (0)
#define PG8_LD8(base, off) __builtin_shufflevector(*(const PG8_LAS v4i_t*)(lds + (base) + (off)[0]), *(const PG8_LAS v4i_t*)(lds + (base) + (off)[1]), 0, 1, 2, 3, 4, 5, 6, 7)
#define PG8_LDA(dst, b, h) do { if constexpr (F8) { _Pragma("unroll") for (int m = 0; m < 4; ++m) dst##8[m] = PG8_LD8(PG8_SA(b, h) + m * 2048, aoffk); } \
        else { _Pragma("unroll") for (int m = 0; m < 4; ++m) _Pragma("unroll") for (int k = 0; k < 2; ++k) dst[m][k] = *(const PG8_LAS bf16x8*)(lds + PG8_SA(b, h) + aoffk[k] + m * 2048); } } while (0)
#define PG8_LDB(dst, b, h) do { if constexpr (F8) { _Pragma("unroll") for (int n = 0; n < 2; ++n) dst##8[n] = PG8_LD8(PG8_SB(b, h) + n * 2048, boffk); } \
        else { _Pragma("unroll") for (int n = 0; n < 2; ++n) _Pragma("unroll") for (int k = 0; k < 2; ++k) dst[n][k] = *(const PG8_LAS bf16x8*)(lds + PG8_SB(b, h) + boffk[k] + n * 2048); } } while (0)
#define PG8_MMA(ai, bj, At, Bt) do { __builtin_amdgcn_s_setprio(1); _Pragma("unroll") for (int m = 0; m < 4; ++m) _Pragma("unroll") for (int n = 0; n < 2; ++n) { \
        if constexpr (F8) asm volatile("v_mfma_scale_f32_16x16x128_f8f6f4 %0, %1, %2, %0, %3, %3 op_sel_hi:[0,0,0]" : "+v"(acc[ai][bj][m][n]) : "v"(Bt##8[n]), "v"(At##8[m]), "v"(f8one)); \
        else { _Pragma("unroll") for (int k = 0; k < 2; ++k) acc[ai][bj][m][n] = __builtin_amdgcn_mfma_f32_16x16x32_bf16(Bt[n][k], At[m][k], acc[ai][bj][m][n], 0, 0, 0); } } __builtin_amdgcn_s_setprio(0); } while (0)
#define PG8_WAIT_V(n) asm volatile("s_waitcnt vmcnt(" #n ")" ::: "memory")
#define PG8_WAIT_L(n) asm volatile("s_waitcnt lgkmcnt(" #n ")" ::: "memory")
#define PG8_BAR __builtin_amdgcn_s_barrier()
#define PG8_SCHED __builtin_amdgcn_sched_barrier(0)
    Unit cur, nxt; int ui = 0;
    if (!S.next(0, cur)) return;
    f32x4 acc[2][2][4][2];
#pragma unroll
    for (int a = 0; a < 2; ++a)
#pragma unroll
        for (int b = 0; b < 2; ++b)
#pragma unroll
            for (int m = 0; m < 4; ++m)
#pragma unroll
                for (int n = 0; n < 2; ++n) acc[a][b][m][n] = (f32x4){0.f, 0.f, 0.f, 0.f};
    bf16x8 At[4][2], B0[2][2], B1[2][2];
    v8i_t At8[4], B08[2], B18[2];
    const int f8one = 0x7f7f7f7f;
    unsigned vc0[2], vc1[2], vn0[2], vn1[2];
#pragma unroll
    for (int i = 0; i < 2; ++i) { if constexpr (GATHER) { vc0[i] = S.arow(0, RA[i]) + CA2[i]; vc1[i] = S.arow(0, HALF + RA[i]) + CA2[i]; } else { vc0[i] = voffA[i]; vc1[i] = voffA[i]; } vn0[i] = vc0[i]; vn1[i] = vc1[i]; }
    const char* cA = GATHER ? (const char*)g.A : (const char*)g.A + (size_t)cur.pm * tstep; const char* cB = (const char*)g.Bt + (size_t)cur.pn * tstep;
    PG8_STAGE(PG8_SB(0, 0), cB, voffB); PG8_STAGE(PG8_SB(0, 1), cB + hstep, voffB); PG8_STAGE(PG8_SA(0, 0), cA, vc0); PG8_STAGE(PG8_SA(0, 1), cA + hA, vc1);
    if (wr == 1) PG8_BAR;
    PG8_WAIT_V(2); PG8_BAR;
    PG8_STAGE(PG8_SB(1, 0), cB + kstep, voffB); PG8_STAGE(PG8_SA(1, 0), cA + kstep, vc0); PG8_STAGE(PG8_SB(1, 1), cB + hstep + kstep, voffB);
    PG8_WAIT_V(6); PG8_BAR;
    for (;;) {
        const bool has_next = S.next(ui + 1, nxt);
        const char* nA = GATHER ? (const char*)g.A : (has_next ? (const char*)g.A + (size_t)nxt.pm * tstep : cA); const char* nB = has_next ? (const char*)g.Bt + (size_t)nxt.pn * tstep : cB;
        if constexpr (GATHER) { if (has_next) {
#pragma unroll
            for (int i = 0; i < 2; ++i) { vn0[i] = S.arow(ui + 1, RA[i]) + CA2[i]; vn1[i] = S.arow(ui + 1, HALF + RA[i]) + CA2[i]; } } }
#pragma unroll 1
        for (int t = 0; t < nt; t += 2) {
            const bool last = (t == nt - 2);
            const char* a1 = cA + (size_t)(t + 1) * kstep;
            const char* a2 = last ? nA : cA + (size_t)(t + 2) * kstep; const char* b2 = last ? nB : cB + (size_t)(t + 2) * kstep;
            const char* a3 = a2 + kstep; const char* b3 = b2 + kstep;
            unsigned vs0[2], vs1[2];
#pragma unroll
            for (int i = 0; i < 2; ++i) { vs0[i] = (GATHER && last) ? vn0[i] : vc0[i]; vs1[i] = (GATHER && last) ? vn1[i] : vc1[i]; }
            PG8_LDB(B0, 0, 0); PG8_LDB(B1, 0, 1); PG8_SCHED; PG8_LDA(At, 0, 0); PG8_STAGE(PG8_SA(1, 1), a1 + hA, vc1);
            PG8_WAIT_V(8); PG8_WAIT_L(0); PG8_BAR; PG8_MMA(0, 0, At, B0); PG8_MMA(0, 1, At, B1); PG8_BAR; PG8_SCHED;
            PG8_LDA(At, 0, 1); PG8_STAGE(PG8_SB(0, 0), b2, voffB); PG8_STAGE(PG8_SB(0, 1), b2 + hstep, voffB); PG8_STAGE(PG8_SA(0, 0), a2, vs0);
            PG8_WAIT_V(8); PG8_WAIT_L(0); PG8_BAR; PG8_MMA(1, 0, At, B0); PG8_MMA(1, 1, At, B1); PG8_BAR; PG8_SCHED;
            PG8_LDB(B0, 1, 0); PG8_LDB(B1, 1, 1); PG8_SCHED; PG8_LDA(At, 1, 0); PG8_STAGE(PG8_SA(0, 1), a2 + hA, vs1);
            PG8_WAIT_V(8); PG8_WAIT_L(0); PG8_BAR; PG8_MMA(0, 0, At, B0); PG8_MMA(0, 1, At, B1); PG8_BAR; PG8_SCHED;
            PG8_LDA(At, 1, 1); PG8_STAGE(PG8_SB(1, 0), b3, voffB); PG8_STAGE(PG8_SB(1, 1), b3 + hstep, voffB); PG8_STAGE(PG8_SA(1, 0), a3, vs0);
            PG8_WAIT_V(8); PG8_WAIT_L(0); PG8_BAR; PG8_MMA(1, 0, At, B0); PG8_MMA(1, 1, At, B1); PG8_BAR; PG8_SCHED;
        }
        if constexpr (ALIGN_EPI) { if (wr == 0) PG8_BAR; }
        if constexpr (F8) asm volatile("s_nop 15\n\ts_nop 15" ::: "memory");
        E(acc, cur, wr, wc, fr, fq);
        if (!has_next) break;
#pragma unroll
        for (int a = 0; a < 2; ++a)
#pragma unroll
            for (int b = 0; b < 2; ++b)
#pragma unroll
                for (int m = 0; m < 4; ++m)
#pragma unroll
                    for (int n = 0; n < 2; ++n) acc[a][b][m][n] = (f32x4){0.f, 0.f, 0.f, 0.f};
        cur = nxt; cA = nA; cB = nB; ++ui;
#pragma unroll
        for (int i = 0; i < 2; ++i) { vc0[i] = vn0[i]; vc1[i] = vn1[i]; }
        if constexpr (ALIGN_EPI) { if (wr == 1) PG8_BAR; }
    }
    PG8_WAIT_V(0);
    if constexpr (!ALIGN_EPI) { if (wr == 0) PG8_BAR; }
    PG8_BAR;
#undef PG8_SA
#undef PG8_SB
#undef PG8_STAGE
#undef PG8_LDA
#undef PG8_LD8
#undef PG8_LDB
#undef PG8_MMA
#undef PG8_WAIT_V
#undef PG8_WAIT_L
#undef PG8_BAR
#undef PG8_SCHED
}
}

constexpr int NWAVES = 8;
constexpr int N_LAUNCHES = MK_N_LAUNCHES;
constexpr int NPHASE = 10;
constexpr int D = 1024, NB = 16, S = 2048, NT = NB * S;
constexpr int NIN = 3232, NINP = 3328, QKVW = 1536, RWP = 1792;
constexpr int NE = 32, CAP = 32768, MAXROWS = 65536 + NE * 256, MAXU = 8;
constexpr float WGU_SCALE = 64.f, WD_SCALE = 32.f, ACT_SCALE = 8.f, OS_SCALE = 16.f;
constexpr size_t MiB = 1u << 20;
constexpr size_t WS_CTL = 0, CTL_ZERO_BYTES = 64 * 1024;
constexpr int CW_CNT = 64, CW_UQ = 3072, CW_BAR = 4096;
constexpr size_t WS_RSTD = 1 * MiB;
constexpr size_t WS_TOKE = 2 * MiB;
constexpr size_t WS_TOKP = 3 * MiB;
constexpr size_t WS_TOKG = 4 * MiB;
constexpr size_t WS_LIST = 8 * MiB;
constexpr size_t WS_WIN = 12 * MiB;
constexpr size_t WS_WOUT = 19 * MiB;
constexpr size_t WS_XB = 22 * MiB;
constexpr size_t WS_MIX = 310 * MiB;
constexpr size_t WS_QKV = 86 * MiB;
constexpr size_t WS_H2 = WS_QKV;
constexpr size_t WS_BON = 5 * MiB;
constexpr size_t WS_WLG = 6 * MiB;
constexpr size_t WS_MT = 182 * MiB, WS_RC = 214 * MiB, WS_NN = 246 * MiB, WS_Y0 = 278 * MiB, WS_VS = 374 * MiB, WS_GG = 406 * MiB;
constexpr size_t WS_WGU = 182 * MiB;
constexpr size_t WS_WD = 246 * MiB;
constexpr size_t WS_ACT = 278 * MiB;
constexpr size_t WS_OSLOT = 352 * MiB;
constexpr size_t WS_SSP = 496 * MiB;
constexpr size_t WS_WRH = 7 * MiB, WS_WRL = 7 * MiB + 128 * 1024;
constexpr size_t WS_END = 498 * MiB;
static_assert(WS_ACT + (size_t)MAXROWS * 512 * 2 <= WS_OSLOT && WS_OSLOT + (size_t)MAXROWS * 1024 * 2 <= WS_END && WS_GG + (size_t)4096 * 4096 * 2 <= WS_END, "ws map");
constexpr int RING_OFF = 0, RING_BYTES = 131072;
constexpr int LDS_BYTES = 163840;
constexpr int LDSCTL_OFF = LDS_BYTES - 1024, MISC_OFF = LDSCTL_OFF + 320;
constexpr int ROWOFF_OFF = LDSCTL_OFF - 8192;
constexpr int TAB_OFF = ROWOFF_OFF - 512;
constexpr int FREE_BYTES = TAB_OFF;
static_assert(ROWOFF_OFF + MAXU * 256 * 4 <= LDSCTL_OFF && RING_BYTES <= FREE_BYTES, "LDS map");

#define GAS __attribute__((address_space(1)))
#define LAS __attribute__((address_space(3)))
typedef unsigned short bf16;
typedef unsigned v4u __attribute__((ext_vector_type(4)));
typedef float f32x4 __attribute__((ext_vector_type(4)));
typedef float f32x2 __attribute__((ext_vector_type(2)));
typedef GAS unsigned gu32;
typedef unsigned v2u __attribute__((ext_vector_type(2)));
typedef short v4i16_t __attribute__((ext_vector_type(4)));
#define RLX_AGENT __ATOMIC_RELAXED, __HIP_MEMORY_SCOPE_AGENT
#define LDS_WAIT() asm volatile("s_waitcnt lgkmcnt(0)" ::: "memory")
#define VM_WAIT() asm volatile("s_waitcnt vmcnt(0)" ::: "memory")
__device__ __forceinline__ float bf2f(bf16 v) { return __builtin_bit_cast(float, (unsigned)v << 16); }
__device__ __forceinline__ unsigned f2bf(float f) { unsigned u = __builtin_bit_cast(unsigned, f); return (u + 0x7fffu + ((u >> 16) & 1u)) >> 16; }
typedef __bf16 bf16x2_t __attribute__((ext_vector_type(2)));
__device__ __forceinline__ unsigned pk2(float lo, float hi) { const f32x2 v = {lo, hi}; return __builtin_bit_cast(unsigned, __builtin_convertvector(v, bf16x2_t)); }
#define LBAR() do { asm volatile("s_waitcnt lgkmcnt(0)" ::: "memory"); __builtin_amdgcn_s_barrier(); asm volatile("" ::: "memory"); } while (0)
__device__ __forceinline__ float wave_sum(float v) {
#pragma unroll
    for (int o = 1; o < 64; o <<= 1) v += __shfl_xor(v, o);
    return v;
}
__device__ __forceinline__ float softplusf(float x) { return fmaxf(x, 0.f) + log1pf(expf(-fabsf(x))); }
__device__ __forceinline__ float sigmoidf(float x) { return 1.f / (1.f + expf(-x)); }

#define XB_TMO      128
#define XB_XCNT(j)  (256  + 64 * (j))
#define XB_XSUB(j)  (1280 + 64 * (j))
#define XB_XGEN(j)  (2304 + 64 * (j))
#define XB_TOP      3328
#define XB_TOPGEN   3392
#define XCD_BAR_WORDS 3456
#define XB_SPIN_CAP (1u << 18)
__device__ __forceinline__ unsigned xb_ld(unsigned* p)              { return __hip_atomic_load(p, __ATOMIC_RELAXED, __HIP_MEMORY_SCOPE_AGENT); }
__device__ __forceinline__ unsigned xb_add(unsigned* p, unsigned v) { return __hip_atomic_fetch_add(p, v, __ATOMIC_RELAXED, __HIP_MEMORY_SCOPE_AGENT); }
__device__ __forceinline__ unsigned xb_xcc_id() { return (unsigned)__builtin_amdgcn_s_getreg((3 << 11) | 20) & 0xFu; }
#define XB_SPIN(cond, bar) do { unsigned _sp = 0; while (cond) { __builtin_amdgcn_s_sleep(1); \
    if ((++_sp & 255u) == 0u) { if (xb_ld(&(bar)[XB_TMO])) break; if (_sp > XB_SPIN_CAP) { atomicAdd(&(bar)[XB_TMO], 1u); break; } } } } while (0)
struct XcdBarrier { unsigned* bar; unsigned x; volatile LAS unsigned* st; };
__device__ __forceinline__ XcdBarrier xcd_barrier_post(unsigned* bar, volatile LAS unsigned* st) {
    XcdBarrier b; b.bar = bar; b.x = xb_xcc_id(); b.st = st;
    if (threadIdx.x == 0) (void)xb_add(&bar[XB_XCNT(b.x)], 1u);
    return b;
}
__device__ __forceinline__ void xcd_barrier_complete(unsigned* bar, unsigned x, unsigned& nloc, unsigned& nx) {
    const unsigned G = gridDim.x * gridDim.y * gridDim.z;
    unsigned sum, cnt, mine, sp = 0u;
    for (;;) {
        sum = 0u; cnt = 0u; mine = 0u;
#pragma unroll
        for (unsigned j = 0; j < 16; ++j) { const unsigned c = xb_ld(&bar[XB_XCNT(j)]); sum += c; cnt += (c > 0u) ? 1u : 0u; mine = (j == x) ? c : mine; }
        if (sum == G) break;
        __builtin_amdgcn_s_sleep(1);
        if ((++sp & 255u) == 0u) { if (xb_ld(&bar[XB_TMO])) break; if (sp > XB_SPIN_CAP) { atomicAdd(&bar[XB_TMO], 1u); break; } }
    }
    nloc = mine > 0u ? mine : 1u; nx = cnt > 0u ? cnt : 1u;
}
__device__ __forceinline__ void xcd_barrier(const XcdBarrier& b) {
    asm volatile("s_waitcnt vmcnt(0)" ::: "memory");
    __syncthreads();
    if (threadIdx.x == 0) {
        unsigned* bar = b.bar;
        __builtin_amdgcn_s_waitcnt(0);
        unsigned nloc = b.st[0], nx = b.st[1];
        if (nloc == 0u) { xcd_barrier_complete(bar, b.x, nloc, nx); b.st[0] = nloc; b.st[1] = nx; }
        const unsigned old = xb_add(&bar[XB_XSUB(b.x)], 1u);
        const unsigned gen = old / nloc;
        if (old + 1u == (gen + 1u) * nloc) {
            __builtin_amdgcn_fence(__ATOMIC_RELEASE, "agent");
            asm volatile("s_waitcnt vmcnt(0)" ::: "memory");
            const unsigned og = xb_add(&bar[XB_TOP], 1u);
            const unsigned tg = og / nx;
            if (og + 1u == (tg + 1u) * nx) xb_add(&bar[XB_TOPGEN], 1u);
            else XB_SPIN(xb_ld(&bar[XB_TOPGEN]) == tg, bar);
            __builtin_amdgcn_fence(__ATOMIC_ACQUIRE, "agent");
            xb_add(&bar[XB_XGEN(b.x)], 1u);
            asm volatile("s_waitcnt vmcnt(0)" ::: "memory");
        } else {
            XB_SPIN(xb_ld(&bar[XB_XGEN(b.x)]) == gen, bar);
            __builtin_amdgcn_fence(__ATOMIC_ACQUIRE, "agent");
            asm volatile("s_waitcnt vmcnt(0)" ::: "memory");
        }
    }
    __syncthreads();
}

namespace rw {
typedef short bf16x8 __attribute__((ext_vector_type(8)));
typedef short s16x4 __attribute__((ext_vector_type(4)));
typedef float f32x16 __attribute__((ext_vector_type(16)));
constexpr int PB = 144;
__device__ __forceinline__ bf16x8 frag_row(const LAS unsigned char* tile, int pitch, int rowbase, int ks, int lane) {
    return *(const LAS bf16x8*)(tile + (rowbase + (lane & 31)) * pitch + (16 * ks + 8 * (lane >> 5)) * 2);
}
__device__ __forceinline__ bf16x8 frag_col(const LAS unsigned char* tile, int pitch, int rowbase, int ks, int lane) {
    const int g = lane >> 4, i = lane & 15;
    const LAS unsigned char* p = tile + (16 * ks + 8 * (g >> 1) + (i >> 2)) * pitch + (rowbase + 16 * (g & 1) + 4 * (i & 3)) * 2;
    const s16x4 lo = __builtin_bit_cast(s16x4, __builtin_amdgcn_ds_read_tr16_b64_v4i16((LAS v4i16_t*)p));
    const s16x4 hi = __builtin_bit_cast(s16x4, __builtin_amdgcn_ds_read_tr16_b64_v4i16((LAS v4i16_t*)(p + 4 * pitch)));
    return __builtin_shufflevector(lo, hi, 0, 1, 2, 3, 4, 5, 6, 7);
}
template <bool AROW, bool BROW, int KS0 = 0, int NKS = 4>
__device__ __forceinline__ void mm(f32x16& acc, const LAS unsigned char* tA, int pA, int rowA, const LAS unsigned char* tB, int pB, int rowB, int lane) {
#pragma unroll
    for (int ks = KS0; ks < KS0 + NKS; ++ks) {
        const bf16x8 a = AROW ? frag_row(tA, pA, rowA, ks, lane) : frag_col(tA, pA, rowA, ks, lane);
        const bf16x8 b = BROW ? frag_row(tB, pB, rowB, ks, lane) : frag_col(tB, pB, rowB, ks, lane);
        acc = __builtin_amdgcn_mfma_f32_32x32x16_bf16(a, b, acc, 0, 0, 0);
    }
}
__device__ __forceinline__ void zero(f32x16& a) {
#pragma unroll
    for (int r = 0; r < 16; ++r) a[r] = 0.f;
}
__device__ __forceinline__ void store_t(LAS unsigned char* tile, int nbase, int mbase, const f32x16& acc, int lane) {
    LAS unsigned char* p = tile + (nbase + (lane & 31)) * PB + (mbase + 4 * (lane >> 5)) * 2;
#pragma unroll
    for (int rg = 0; rg < 4; ++rg) *(LAS v2u*)(p + 16 * rg) = (v2u){pk2(acc[4 * rg], acc[4 * rg + 1]), pk2(acc[4 * rg + 2], acc[4 * rg + 3])};
}
__device__ __forceinline__ void store_t_g(bf16* tile, int nbase, int mbase, const f32x16& acc, int lane) {
    bf16* p = tile + (nbase + (lane & 31)) * 64 + (mbase + 4 * (lane >> 5));
#pragma unroll
    for (int rg = 0; rg < 4; ++rg) *(uint2*)(p + 8 * rg) = make_uint2(pk2(acc[4 * rg], acc[4 * rg + 1]), pk2(acc[4 * rg + 2], acc[4 * rg + 3]));
}
template <bool STRICT>
__device__ __forceinline__ void tril(f32x16& acc, int mbase, int nbase, int lane) {
    const int n = nbase + (lane & 31), m0 = mbase + 4 * (lane >> 5);
#pragma unroll
    for (int r = 0; r < 16; ++r) { const int m = m0 + (r & 3) + 8 * (r >> 2); const bool keep = STRICT ? (m > n) : (m >= n); acc[r] = keep ? acc[r] : 0.f; }
}
}

struct TrItem { const float* W; int K, N, k0, n0; bf16* dst; const float* kscale; float f8scale; };
__device__ __forceinline__ void p0_tr_load(float (&r)[32], const TrItem& it, int lane) {
#pragma unroll
    for (int i = 0; i < 32; ++i) { const int kk = 2 * i + (lane >> 5); r[i] = it.W[(size_t)(it.k0 + kk) * it.N + it.n0 + (lane & 31)]; }
}
__device__ __forceinline__ void p0_tr_store(const float (&r)[32], const TrItem& it, LAS float* scr, int lane) {
#pragma unroll
    for (int i = 0; i < 32; ++i) { const int kk = 2 * i + (lane >> 5); float v = r[i]; if (it.kscale) v *= it.kscale[it.k0 + kk]; scr[kk * 33 + (lane & 31)] = v; }
    LDS_WAIT(); asm volatile("" ::: "memory");
    const int c = lane & 7;
#pragma unroll
    for (int j = 0; j < 4; ++j) { const int n = (lane >> 3) + 8 * j; const LAS float* s = scr + (8 * c) * 33 + n;
        if (it.f8scale != 0.f) { const float f = it.f8scale;
            *(GAS unsigned long long*)((GAS unsigned char*)it.dst + (size_t)n * it.K + it.k0 + 8 * c) = (unsigned long long)pg8::pk4_fp8(s[0 * 33] * f, s[1 * 33] * f, s[2 * 33] * f, s[3 * 33] * f) | ((unsigned long long)pg8::pk4_fp8(s[4 * 33] * f, s[5 * 33] * f, s[6 * 33] * f, s[7 * 33] * f) << 32); }
        else { v4u o; o.x = pk2(s[0 * 33], s[1 * 33]); o.y = pk2(s[2 * 33], s[3 * 33]); o.z = pk2(s[4 * 33], s[5 * 33]); o.w = pk2(s[6 * 33], s[7 * 33]);
            *(GAS v4u*)(it.dst + (size_t)n * it.K + it.k0 + 8 * c) = o; } }
    LDS_WAIT(); asm volatile("" ::: "memory");
}
#define P0_TR_LOOP(first, stride, nitems, scr, MK) do { float ra_[32], rb_[32]; \
    for (int it_ = (first); it_ < (nitems); it_ += 2 * (stride)) { const TrItem ia_ = MK(it_); const bool hb_ = it_ + (stride) < (nitems); const TrItem ib_ = MK(hb_ ? it_ + (stride) : it_); \
        p0_tr_load(ra_, ia_, lane); if (hb_) p0_tr_load(rb_, ib_, lane); p0_tr_store(ra_, ia_, scr, lane); if (hb_) p0_tr_store(rb_, ib_, scr, lane); } } while (0)

struct Args { const float* in[23]; float* out; unsigned char* ws; int ph_lo, ph_hi; };
__global__ void __launch_bounds__(NWAVES * 64, 2) fwd(Args args) {
    extern __shared__ __attribute__((aligned(16))) unsigned char lds_raw[];
    LAS unsigned char* lds = (LAS unsigned char*)lds_raw;
    volatile LAS unsigned* MISC = (volatile LAS unsigned*)(lds + MISC_OFF);
    int tid = threadIdx.x, lane = tid & 63; const int wave = __builtin_amdgcn_readfirstlane(tid >> 6);
    const int G = gridDim.x, bx = blockIdx.x;
    const int gw = bx * NWAVES + wave, NGW = G * NWAVES;
#define PHASE_ENTRY() do { asm volatile("" : "+v"(tid)); lane = tid & 63; } while (0)
    unsigned char* ws = args.ws;
    gu32* ctl = (gu32*)(ws + WS_CTL);
    const float* x = args.in[0]; float* out = args.out;
    float* rstd1 = (float*)(ws + WS_RSTD);
    int2* toke = (int2*)(ws + WS_TOKE); int2* tokp = (int2*)(ws + WS_TOKP); float2* tokg = (float2*)(ws + WS_TOKG); int* list = (int*)(ws + WS_LIST);
    bf16* Win_t = (bf16*)(ws + WS_WIN); bf16* Wout_t = (bf16*)(ws + WS_WOUT); bf16* xb = (bf16*)(ws + WS_XB); bf16* mix = (bf16*)(ws + WS_MIX);
    bf16* qkv = (bf16*)(ws + WS_QKV); bf16* h2 = (bf16*)(ws + WS_H2); bf16* rwraw = (bf16*)out;
    bf16 *MTg = (bf16*)(ws + WS_MT), *RCg = (bf16*)(ws + WS_RC), *VSg = (bf16*)(ws + WS_VS), *GGg = (bf16*)(ws + WS_GG), *WLg = (bf16*)(ws + WS_WLG); bf16 *NNg = (bf16*)(ws + WS_NN), *Y0g = (bf16*)(ws + WS_Y0); float* BONg = (float*)(ws + WS_BON);
    bf16* Wgu_t = (bf16*)(ws + WS_WGU); bf16* Wd_t = (bf16*)(ws + WS_WD); bf16* act = (bf16*)(ws + WS_ACT); bf16* oslot = (bf16*)(ws + WS_OSLOT);
    int* cntg = (int*)(ctl + CW_CNT);
    float* SSPg = (float*)(ws + WS_SSP); bf16* WRh = (bf16*)(ws + WS_WRH); bf16* WRl = (bf16*)(ws + WS_WRL);

    for (int u = tid; u < (LDS_BYTES - LDSCTL_OFF) / 4; u += NWAVES * 64) ((LAS unsigned*)(lds + LDSCTL_OFF))[u] = 0u;
    __syncthreads();
    XcdBarrier bar; bar.bar = (unsigned*)(ctl + CW_BAR); bar.x = 0; bar.st = nullptr;
    if (N_LAUNCHES != NPHASE) bar = xcd_barrier_post((unsigned*)(ctl + CW_BAR), MISC + 8);
#define GRID_BAR() do { if (N_LAUNCHES != NPHASE) xcd_barrier(bar); } while (0)
    const int lo = args.ph_lo, hi = args.ph_hi;
#ifndef PH_MASK
#define PH_MASK 0x3ff
#endif
#define IN(k) (((PH_MASK >> (k)) & 1) && lo <= (k) && (k) < hi)
#define BOTH(k) (IN(k) && IN((k) + 1))

    if (IN(0)) {
        PHASE_ENTRY();
        LAS float* scr = (LAS float*)(lds + RING_OFF + wave * 16384);
        constexpr int I_IN = (D / 64) * (NIN / 32), I_OUT = (D / 64) * (D / 32);
        auto mk0 = [&](int it) { TrItem t;
            if (it < I_IN) { const int nblk = NIN / 32, kb = it / nblk, nb = it % nblk; t = TrItem{args.in[2], D, NIN, 64 * kb, 32 * nb, Win_t + (size_t)(32 * nb) * D, args.in[1], 0.f}; }
            else { const int r = it - I_IN, nblk = D / 32, kb = r / nblk, nb = r % nblk; t = TrItem{args.in[16], D, D, 64 * kb, 32 * nb, Wout_t + (size_t)(32 * nb) * D, nullptr, 0.f}; }
            return t; };
        P0_TR_LOOP(gw, NGW, I_IN + I_OUT, scr, mk0);
        for (int i = bx * 512 + tid; i < 8 * 64 * 160; i += G * 512) { const int hh_ = i / 10240, n = (i / 160) % 64, k = i % 160; const int col = hh_ * 64 + n;
            const float v = (k < 32) ? args.in[7][k * 512 + col] : (k < 64) ? args.in[9][(k - 32) * 512 + col] : args.in[10][(k - 64) * 512 + col]; WLg[i] = (bf16)f2bf(v); }
        for (int i = bx * 512 + tid; i < 48 * 1024; i += G * 512) { const int n = i >> 10, k = i & 1023; float w = 0.f;
            if (n < 32) w = args.in[19][k * 32 + n] * args.in[17][k]; else if (n < 36) w = args.in[18][k * 4 + (n - 32)] * args.in[17][k];
            const unsigned hb = f2bf(w); WRh[i] = (bf16)hb; WRl[i] = (bf16)f2bf(w - __builtin_bit_cast(float, hb << 16)); }
        for (int i = bx * 512 + tid; i < (NINP - NIN) * D / 8; i += G * 512) ((GAS v4u*)(Win_t + (size_t)NIN * D))[i] = (v4u){0u, 0u, 0u, 0u};
        {
            f32x4 va[4][4], vb[4][4];
#define P0_LOADROWS(V, M0) do { _Pragma("unroll") for (int q4 = 0; q4 < 4; ++q4) { const GAS f32x4* xr = (const GAS f32x4*)(x + (size_t)((M0) + q4 * NGW) * D) + 2 * lane; \
                V[q4][0] = xr[0]; V[q4][1] = xr[1]; V[q4][2] = xr[128]; V[q4][3] = xr[129]; } } while (0)
#define P0_DOROWS(V, M0) do { _Pragma("unroll") for (int q4 = 0; q4 < 4; ++q4) { const int m = (M0) + q4 * NGW; float s = 0.f; \
                _Pragma("unroll") for (int j = 0; j < 4; ++j) s += (V[q4][j].x * V[q4][j].x + V[q4][j].y * V[q4][j].y) + (V[q4][j].z * V[q4][j].z + V[q4][j].w * V[q4][j].w); \
                s = wave_sum(s); const float rs_ = rsqrtf(s * (1.f / D) + 1e-6f); if (lane == 0) rstd1[m] = 1.f / rs_; \
                _Pragma("unroll") for (int j = 0; j < 4; ++j) V[q4][j] = V[q4][j] * rs_; \
                GAS v4u* o16 = (GAS v4u*)(xb + (size_t)m * D) + lane; \
                o16[0] = (v4u){pk2(V[q4][0].x, V[q4][0].y), pk2(V[q4][0].z, V[q4][0].w), pk2(V[q4][1].x, V[q4][1].y), pk2(V[q4][1].z, V[q4][1].w)}; \
                o16[64] = (v4u){pk2(V[q4][2].x, V[q4][2].y), pk2(V[q4][2].z, V[q4][2].w), pk2(V[q4][3].x, V[q4][3].y), pk2(V[q4][3].z, V[q4][3].w)}; } } while (0)
            static_assert(NT % (8 * 2048) == 0, "row pipeline: two steps per trip at 2048 waves");
            P0_LOADROWS(va, gw);
            for (int m0 = gw; m0 < NT; m0 += 8 * NGW) {
                P0_LOADROWS(vb, m0 + 4 * NGW);
                P0_DOROWS(va, m0);
                if (m0 + 8 * NGW < NT) P0_LOADROWS(va, m0 + 8 * NGW);
                P0_DOROWS(vb, m0 + 4 * NGW);
            }
#undef P0_LOADROWS
#undef P0_DOROWS
        }
        if (BOTH(0)) GRID_BAR();
    }

    if (IN(1)) {
        PHASE_ENTRY();
        pg8::Gemm g{xb, Win_t, NT, NINP, D}; pg8::StaticOrder So; So.init(NT, NINP, G, bx);
        pg8::EpiProj E{qkv, rwraw};
        pg8::gemm_phase<pg8::EpiProj, pg8::StaticOrder, true, false>(lds + RING_OFF, g, So, E);
        if (BOTH(1)) GRID_BAR();
    }

    if (IN(2)) {
        PHASE_ENTRY();
        using namespace rw;
        const float *mu = args.in[5], *w0 = args.in[6], *a0 = args.in[8], *k_k = args.in[11], *k_a = args.in[12], *r_k = args.in[13];
        LAS unsigned char* L = lds + RING_OFF;
        constexpr int XP = 336, LP = 272;
        LAS unsigned char* XL = L; LAS unsigned char* RAWt = L + 21504; LAS unsigned char* WLt = L + 130688; LAS unsigned char* LDt = L + 46464; LAS unsigned char* At = L + 63872; LAS unsigned char* Gt = L + 73088;
        static_assert(130688 + 21504 + 640 <= FREE_BYTES, "R1 LDS map");
        LAS unsigned char* Ac = L + 82304; LAS unsigned char* Rc = Ac + 9216; LAS unsigned char* Bc = Rc + 9216; LAS unsigned char* Kc = Bc + 9216; LAS unsigned char* Vc = Kc + 9216;
        LAS float* seg = (LAS float*)(L + 128384); LAS float* WC = (LAS float*)(L + 130432);
        LAS unsigned char* Xa = L; LAS unsigned char* Xb = L + 9216; LAS unsigned char* Tta = L + 18432; LAS unsigned char* Ttb = L + 27648; LAS unsigned char* S5 = L + 36864; LAS unsigned char* S6 = L + 46080;
        const int wq = wave & 3, qi = wq >> 1, qj = wq & 1, hh = lane >> 5, l31 = lane & 31;
        const bool quadA = wave < 4;
        const int vcu = (G % 8 == 0) ? (bx % 8) * (G / 8) + bx / 8 : bx;
        const int h = vcu & 7;
        {
            for (int i = tid; i < 1280; i += 512) { const int t = i / 20, ch = i - t * 20; *(LAS v4u*)(WLt + t * XP + ch * 16) = *(const v4u*)(WLg + ((size_t)h * 64 + t) * 160 + 8 * ch); }
        }
        LAS float* MUl = (LAS float*)(WLt + 21504);
        for (int i = tid; i < 160; i += 512) MUl[i] = mu[1536 + i];
        int l0t[3], l0c[3];
#pragma unroll
        for (int n = 0; n < 3; ++n) { const int i = tid + 512 * n; const int t = (i < 1280) ? i / 20 : 0, ch = (i < 1280) ? i - (i / 20) * 20 : 0; l0t[n] = t; l0c[n] = ch;
        }
        const int chn = h * 64 + lane, w8 = wave * 8;
        const float mur = mu[chn], muk = mu[512 + chn], muv = mu[1024 + chn];
        const float kkc = k_k[chn], kac = k_a[chn], rkc = r_k[chn];
        const float w0n = w0[h * 64 + 32 * qj + l31], a0n = a0[h * 64 + 32 * qj + l31];
        v4u pcu[3], ppu[3], praw[4]; int rwg[4], rwl[4];
#pragma unroll
        for (int n = 0; n < 4; ++n) { const int q_ = tid + 512 * n, rr = q_ / 24, rem = q_ - rr * 24; rwg[n] = (rr - 1) * RWP + (rem >> 3) * 512 + (rem & 7) * 8; rwl[n] = (q_ < 1560) ? rr * 384 + (rem >> 3) * 128 + (rem & 7) * 16 : -1; }
#define R1_PREFETCH(CI) do { const int c_ = ((CI) >> 3) & 31, b_ = (CI) >> 8; const bf16* raw_ = rwraw + (size_t)(b_ * S + c_ * 64) * RWP; \
            _Pragma("unroll") for (int n = 0; n < 3; ++n) { const bf16* cp = raw_ + (size_t)l0t[n] * RWP + 1536 + 8 * l0c[n]; pcu[n] = (v4u){0u, 0u, 0u, 0u}; ppu[n] = (v4u){0u, 0u, 0u, 0u}; \
                if (tid + 512 * n < 1280) { pcu[n] = *(const v4u*)cp; if (c_ * 64 + l0t[n] > 0) ppu[n] = *(const v4u*)(cp - RWP); } } \
            _Pragma("unroll") for (int n = 0; n < 4; ++n) { praw[n] = (v4u){0u, 0u, 0u, 0u}; if (rwl[n] >= 0 && (rwl[n] >= 384 || c_ > 0)) praw[n] = *(const v4u*)(raw_ + h * 64 + rwg[n]); } } while (0)
        LBAR();
        if (vcu < NB * 32 * 8) R1_PREFETCH(vcu);
        for (int ci = vcu; ci < NB * 32 * 8; ci += G) {
            const int c = (ci >> 3) & 31, b = ci >> 8;
            const int row0 = b * S + c * 64;
            const int cx = (b * 8 + h) * 32 + c;
#pragma unroll
            for (int n = 0; n < 4; ++n) if (rwl[n] >= 0) *(LAS v4u*)(RAWt + rwl[n]) = praw[n];
#pragma unroll
            for (int n = 0; n < 3; ++n) if (tid + 512 * n < 1280) {
                const int t = l0t[n], ch = l0c[n];
                const v4u cu = pcu[n], pu = ppu[n]; const f32x4 m0 = *(const LAS f32x4*)(MUl + 8 * ch), m1 = *(const LAS f32x4*)(MUl + 8 * ch + 4);
                float xv[8];
#pragma unroll
                for (int j = 0; j < 4; ++j) {
                    const unsigned cw = cu[j], pw = pu[j];
                    const float c0 = __builtin_bit_cast(float, cw << 16), c1 = __builtin_bit_cast(float, cw & 0xffff0000u), p0 = __builtin_bit_cast(float, pw << 16), p1 = __builtin_bit_cast(float, pw & 0xffff0000u);
                    const float ma = (j < 2) ? m0[2 * j] : m1[(2 * j) & 3], mb = (j < 2) ? m0[2 * j + 1] : m1[(2 * j + 1) & 3];
                    xv[2 * j] = c0 + (p0 - c0) * ma; xv[2 * j + 1] = c1 + (p1 - c1) * mb; }
#pragma unroll
                for (int j = 0; j < 8; ++j) { if (ch < 4) xv[j] = 1.f - 2.f * __builtin_amdgcn_rcpf(1.f + __expf(2.f * xv[j])); else if (ch >= 8) xv[j] = __builtin_amdgcn_rcpf(1.f + __expf(-xv[j])); }
                v4u o; o.x = pk2(xv[0], xv[1]); o.y = pk2(xv[2], xv[3]); o.z = pk2(xv[4], xv[5]); o.w = pk2(xv[6], xv[7]);
                *(LAS v4u*)(XL + t * XP + ch * 16) = o;
            }
            LBAR();
            {
                f32x16 u0, u1; zero(u0); zero(u1);
                const int n = 32 * qj + l31;
                if (quadA) {
                    mm<true, true, 0, 2>(u0, XL, XP, 32 * qi, WLt, XP, 32 * qj, lane);
                    mm<true, true, 2, 2>(u1, XL, XP, 32 * qi, WLt, XP, 32 * qj, lane);
#pragma unroll
                    for (int r = 0; r < 16; ++r) { u0[r] = -0.6065306597f * __builtin_amdgcn_rcpf(1.f + __expf(-(u0[r] + w0n))); u1[r] = __builtin_amdgcn_rcpf(1.f + __expf(-(u1[r] + a0n))); }
                    LAS unsigned char* p = LDt + n * LP + (32 * qi + 4 * hh) * 4;
#pragma unroll
                    for (int rg = 0; rg < 4; ++rg) *(LAS f32x4*)(p + 32 * rg) = (f32x4){u0[4 * rg], u0[4 * rg + 1], u0[4 * rg + 2], u0[4 * rg + 3]};
                    store_t(At, 32 * qj, 32 * qi, u1, lane);
                } else {
                    mm<true, true, 4, 6>(u0, XL, XP, 32 * qi, WLt, XP, 32 * qj, lane);
                    store_t(Gt, 32 * qj, 32 * qi, u0, lane);
                }
            }
            LBAR();
            {
                const int k = lane;
                const LAS unsigned char* rwp = RAWt + w8 * 384 + 2 * k;
                float pr = bf2f(*(const LAS bf16*)(rwp)), pk = bf2f(*(const LAS bf16*)(rwp + 128)), pv = bf2f(*(const LAS bf16*)(rwp + 256));
                const v4u au = *(const LAS v4u*)(At + k * PB + w8 * 2);
                const v4u gu = *(const LAS v4u*)(Gt + k * PB + w8 * 2);
                const f32x4 l0 = *(const LAS f32x4*)(LDt + k * LP + w8 * 4), l1 = *(const LAS f32x4*)(LDt + k * LP + w8 * 4 + 16);
                float av[8], ldv[8], rs[8], kp[8], na[8], bb[8], vs[8];
#pragma unroll
                for (int j = 0; j < 4; ++j) { av[2 * j] = __builtin_bit_cast(float, au[j] << 16); av[2 * j + 1] = __builtin_bit_cast(float, au[j] & 0xffff0000u); ldv[j] = l0[j]; ldv[4 + j] = l1[j]; }
                float red[16], kkv[8];
#pragma unroll
                for (int tt = 0; tt < 8; ++tt) {
                    const float cr = bf2f(*(const LAS bf16*)(rwp + (tt + 1) * 384)), ck = bf2f(*(const LAS bf16*)(rwp + (tt + 1) * 384 + 128)), cv = bf2f(*(const LAS bf16*)(rwp + (tt + 1) * 384 + 256));
                    const float r = cr + (pr - cr) * mur, kx = ck + (pk - ck) * muk, v = cv + (pv - cv) * muv; pr = cr; pk = ck; pv = cv;
                    const float kk = kx * kkc;
                    kp[tt] = kx * (1.f + (av[tt] - 1.f) * kac); kkv[tt] = kk; rs[tt] = r; vs[tt] = v;
                    red[tt] = kk * kk; red[8 + tt] = r * kp[tt] * rkc;
                }
                {
                    const bool u5 = (lane & 32) != 0, u4 = (lane & 16) != 0, u3 = (lane & 8) != 0, u2 = (lane & 4) != 0;
#define RS_STEP(v, n, up, msk) do { _Pragma("unroll") for (int i = 0; i < (n) / 2; ++i) { const float keep = (up) ? v[i + (n) / 2] : v[i]; const float send = (up) ? v[i] : v[i + (n) / 2]; v[i] = keep + __shfl_xor(send, msk); } } while (0)
                    RS_STEP(red, 16, u5, 32); RS_STEP(red, 8, u4, 16); RS_STEP(red, 4, u3, 8); RS_STEP(red, 2, u2, 4);
#undef RS_STEP
                    red[0] += __shfl_xor(red[0], 2); red[0] += __shfl_xor(red[0], 1);
                    if ((lane & 3) == 0 && lane >= 32) BONg[(size_t)cx * 64 + w8 + (lane >> 2) - 8] = red[0];
                }
#pragma unroll
                for (int tt = 0; tt < 8; ++tt) { const float ss = __shfl(red[0], 4 * tt); const float kkn = kkv[tt] * __builtin_amdgcn_rsqf(fmaxf(ss, 1e-24f)); na[tt] = -kkn; bb[tt] = kkn * av[tt]; }
                float cl[8]; float run = 0.f;
#pragma unroll
                for (int tt = 0; tt < 8; ++tt) { run += ldv[tt]; cl[tt] = run; }
                seg[wave * 64 + k] = run;
                LBAR();
                float off = 0.f, tot = 0.f;
#pragma unroll
                for (int w2 = 0; w2 < 8; ++w2) { const float sgm = seg[w2 * 64 + k]; tot += sgm; off += (w2 < wave) ? sgm : 0.f; }
                if (wave == 0) WC[k] = __expf(tot);
                float oa[8], orr[8], ob[8], ok[8];
#pragma unroll
                for (int tt = 0; tt < 8; ++tt) { const float cc = cl[tt] + off; const float wc = __expf(cc), winv = __expf(-cc), wp = __expf(cc - ldv[tt]);
                    oa[tt] = na[tt] * wp; orr[tt] = rs[tt] * wc; ob[tt] = bb[tt] * winv; ok[tt] = kp[tt] * winv; }
#define RW_PACK8(x) ((v4u){pk2(x[0], x[1]), pk2(x[2], x[3]), pk2(x[4], x[5]), pk2(x[6], x[7])})
                *(LAS v4u*)(Ac + k * PB + w8 * 2) = RW_PACK8(oa); *(LAS v4u*)(Rc + k * PB + w8 * 2) = RW_PACK8(orr); *(LAS v4u*)(Bc + k * PB + w8 * 2) = RW_PACK8(ob);
                *(LAS v4u*)(Kc + k * PB + w8 * 2) = RW_PACK8(ok); { const v4u vpk = RW_PACK8(vs); *(LAS v4u*)(Vc + k * PB + w8 * 2) = vpk;
                    *(v4u*)(VSg + (size_t)cx * 4096 + k * 64 + w8) = vpk; *(v4u*)(GGg + (size_t)cx * 4096 + k * 64 + w8) = gu; }
#undef RW_PACK8
            }
            if (ci + G < NB * 32 * 8) R1_PREFETCH(ci + G);
            LBAR();
            const int mb = 32 * qi, nb = 32 * qj;
            f32x16 acc, Tacc;
            zero(acc);
            if (quadA) { mm<false, false>(acc, Ac, PB, mb, Bc, PB, nb, lane); tril<true>(acc, mb, nb, lane); store_t(Xa, nb, mb, acc, lane); }
            else       { mm<false, false>(acc, Ac, PB, mb, Kc, PB, nb, lane); tril<true>(acc, mb, nb, lane); store_t(S5, nb, mb, acc, lane); }
            LBAR();
            zero(acc);
            if (quadA) { mm<false, true>(acc, Xa, PB, mb, Xa, PB, nb, lane); store_t(Xb, nb, mb, acc, lane); }
            else {
                mm<false, true>(acc, S5, PB, mb, Vc, PB, nb, lane); store_t(S6, nb, mb, acc, lane);
                const LAS unsigned char* p = Xa + (nb + l31) * PB + (mb + 4 * hh) * 2;
#pragma unroll
                for (int rg = 0; rg < 4; ++rg) { const v2u t2 = *(const LAS v2u*)(p + 16 * rg);
                    Tacc[4 * rg] = __builtin_bit_cast(float, t2.x << 16); Tacc[4 * rg + 1] = __builtin_bit_cast(float, t2.x & 0xffff0000u); Tacc[4 * rg + 2] = __builtin_bit_cast(float, t2.y << 16); Tacc[4 * rg + 3] = __builtin_bit_cast(float, t2.y & 0xffff0000u); }
#pragma unroll
                for (int r = 0; r < 16; ++r) { const int m = mb + 4 * hh + (r & 3) + 8 * (r >> 2); if (m == nb + l31) Tacc[r] += 1.f; }
                store_t(Tta, nb, mb, Tacc, lane);
            }
            LBAR();
#define RW_NEUMANN(XS, XD, TS, TD) do { if (quadA) { zero(acc); mm<false, true>(acc, XS, PB, mb, XS, PB, nb, lane); store_t(XD, nb, mb, acc, lane); } \
                else { mm<false, true>(Tacc, TS, PB, mb, XS, PB, nb, lane); store_t(TD, nb, mb, Tacc, lane); } LBAR(); } while (0)
            RW_NEUMANN(Xb, Xa, Tta, Ttb);
            RW_NEUMANN(Xa, Xb, Ttb, Tta);
            RW_NEUMANN(Xb, Xa, Tta, Ttb);
            RW_NEUMANN(Xa, Xb, Ttb, Tta);
#undef RW_NEUMANN
            if (quadA) { zero(acc); mm<false, false>(acc, Rc, PB, mb, Bc, PB, nb, lane); tril<false>(acc, mb, nb, lane); store_t(Xa, nb, mb, acc, lane); }
            else       { mm<false, true>(Tacc, Tta, PB, mb, Xb, PB, nb, lane); store_t(Ttb, nb, mb, Tacc, lane); }
            LBAR();
            zero(acc);
            if (quadA) { mm<false, false>(acc, Rc, PB, mb, Kc, PB, nb, lane); tril<false>(acc, mb, nb, lane); store_t(Xb, nb, mb, acc, lane); }
            else       { mm<false, true>(acc, Ttb, PB, mb, Ac, PB, nb, lane); store_t(S5, nb, mb, acc, lane); }
            LBAR();
            zero(acc);
            if (quadA) {
                mm<true, true>(acc, S5, PB, mb, Bc, PB, nb, lane);
                const float wcn = WC[nb + l31];
#pragma unroll
                for (int r = 0; r < 16; ++r) { const int m = mb + 4 * hh + (r & 3) + 8 * (r >> 2); acc[r] = (acc[r] + ((m == nb + l31) ? 1.f : 0.f)) * wcn; }
                store_t_g(MTg + (size_t)cx * 4096, nb, mb, acc, lane);
            } else { mm<false, true>(acc, Ttb, PB, mb, S6, PB, nb, lane); store_t(Tta, nb, mb, acc, lane); }
            LBAR();
            zero(acc);
            if (quadA) {
                mm<false, true>(acc, Xa, PB, mb, S5, PB, nb, lane);
                const LAS unsigned char* p = Rc + (nb + l31) * PB + (mb + 4 * hh) * 2;
#pragma unroll
                for (int rg = 0; rg < 4; ++rg) { const v2u t2 = *(const LAS v2u*)(p + 16 * rg);
                    acc[4 * rg] += __builtin_bit_cast(float, t2.x << 16); acc[4 * rg + 1] += __builtin_bit_cast(float, t2.x & 0xffff0000u); acc[4 * rg + 2] += __builtin_bit_cast(float, t2.y << 16); acc[4 * rg + 3] += __builtin_bit_cast(float, t2.y & 0xffff0000u); }
                store_t_g(RCg + (size_t)cx * 4096, nb, mb, acc, lane);
                zero(acc);
                mm<true, true>(acc, Tta, PB, mb, Bc, PB, nb, lane); mm<true, true>(acc, Vc, PB, mb, Kc, PB, nb, lane);
                const float wcn = WC[nb + l31];
                bf16* np = NNg + (size_t)cx * 4096 + ((qi * 2 + qj) * 64 + lane) * 16;
                *(v4u*)np = (v4u){pk2(acc[0] * wcn, acc[1] * wcn), pk2(acc[2] * wcn, acc[3] * wcn), pk2(acc[4] * wcn, acc[5] * wcn), pk2(acc[6] * wcn, acc[7] * wcn)};
                *(v4u*)(np + 8) = (v4u){pk2(acc[8] * wcn, acc[9] * wcn), pk2(acc[10] * wcn, acc[11] * wcn), pk2(acc[12] * wcn, acc[13] * wcn), pk2(acc[14] * wcn, acc[15] * wcn)};
            } else {
                mm<true, false>(acc, Tta, PB, mb, Xa, PB, nb, lane); mm<true, false>(acc, Vc, PB, mb, Xb, PB, nb, lane);
                bf16* yp = Y0g + (size_t)cx * 4096 + ((qi * 2 + qj) * 64 + lane) * 16;
                *(v4u*)yp = (v4u){pk2(acc[0], acc[1]), pk2(acc[2], acc[3]), pk2(acc[4], acc[5]), pk2(acc[6], acc[7])};
                *(v4u*)(yp + 8) = (v4u){pk2(acc[8], acc[9]), pk2(acc[10], acc[11]), pk2(acc[12], acc[13]), pk2(acc[14], acc[15])};
            }
            LBAR();
        }
#undef R1_PREFETCH
        if (BOTH(2)) GRID_BAR();
    }

    if (IN(3)) {
        PHASE_ENTRY();
        {
        using namespace rw;
        if (bx < NB * 8) {
            const float *ln_w = args.in[14], *ln_b = args.in[15];
            const int b = bx >> 3, h = bx & 7;
            LAS unsigned char* L = lds + RING_OFF;
            const int wq = wave & 3, qi = wq >> 1, qj = wq & 1, hh = lane >> 5, l31 = lane & 31;
            const int trow = tid >> 3, tch = tid & 7;
#define R2_ST(p) (L + (p) * 9216)
#define R2_BUF(p) (L + 18432 + (p) * 45568)
#define R2_YL(p) ((LAS bf16*)(R2_BUF(p) + 37376))
#define R2_ML(p) (R2_BUF(p))
#define R2_RL(p) (R2_BUF(p) + 9216)
#define R2_VL(p) (R2_BUF(p) + 18432)
#define R2_GL(p) (R2_BUF(p) + 27648)
#define R2_BL(p) ((LAS float*)(R2_BUF(p) + 36864))
            LAS float* LNW = (LAS float*)(L + 18432 + 2 * 45568); static_assert(18432 + 2 * 45568 + 512 <= FREE_BYTES, "R2 LDS map"); LAS float* LNB = LNW + 64;
            const size_t cx0 = (size_t)(b * 8 + h) * 32;
            for (int i = tid; i < 9216 / 16; i += 512) *(LAS v4u*)(L + i * 16) = (v4u){0u, 0u, 0u, 0u};
            if (tid < 64) { LNW[tid] = ln_w[h * 64 + tid]; LNB[tid] = ln_b[h * 64 + tid]; }
            v4u mreg, rreg, vreg, greg, breg, yreg0;
#define R2_LOADT(c_) do { const size_t o_ = (cx0 + (c_)) * 4096 + trow * 64 + tch * 8; mreg = *(const v4u*)(MTg + o_); rreg = *(const v4u*)(RCg + o_); vreg = *(const v4u*)(VSg + o_); greg = *(const v4u*)(GGg + o_); \
                yreg0 = *(const v4u*)(Y0g + (cx0 + (c_)) * 4096 + tid * 8); \
                if (tid < 16) breg = *(const v4u*)(BONg + (cx0 + (c_)) * 64 + tid * 4); } while (0)
#define R2_WRITET(p_) do { const int o_ = trow * PB + tch * 16; *(LAS v4u*)(R2_ML(p_) + o_) = mreg; *(LAS v4u*)(R2_RL(p_) + o_) = rreg; *(LAS v4u*)(R2_VL(p_) + o_) = vreg; *(LAS v4u*)(R2_GL(p_) + o_) = greg; \
                *(LAS v4u*)(R2_YL(p_) + tid * 8) = yreg0; \
                if (tid < 16) *(LAS v4u*)(R2_BL(p_) + tid * 4) = breg; } while (0)
            breg = (v4u){0u, 0u, 0u, 0u};
            R2_LOADT(0); R2_WRITET(0); R2_LOADT(1);
            v4u pn0 = (v4u){0u, 0u, 0u, 0u}, pn1 = pn0;
#define R2_LOADACC(c_) do { if (wave < 4) { const bf16* np = NNg + (cx0 + (c_)) * 4096 + ((qi * 2 + qj) * 64 + lane) * 16; pn0 = *(const v4u*)np; pn1 = *(const v4u*)(np + 8); } } while (0)
#define R2_UNPK(dst, i0, w) do { dst[i0] = __builtin_bit_cast(float, (w) << 16); dst[(i0) + 1] = __builtin_bit_cast(float, (w) & 0xffff0000u); } while (0)
            R2_LOADACC(0);
            LBAR();
            for (int c = 0; c < 32; ++c) {
                const int p = c & 1;
                if (c + 1 < 32) R2_WRITET(p ^ 1);
                if (c + 2 < 32) R2_LOADT(c + 2);
                if (wave < 4) {
                    f32x16 acc;
#pragma unroll
                    for (int i = 0; i < 4; ++i) { R2_UNPK(acc, 2 * i, pn0[i]); R2_UNPK(acc, 8 + 2 * i, pn1[i]); }
                    if (c + 1 < 32) R2_LOADACC(c + 1);
                    mm<false, true>(acc, R2_ST(p), PB, 32 * qi, R2_ML(p), PB, 32 * qj, lane);
                    store_t(R2_ST(p ^ 1), 32 * qj, 32 * qi, acc, lane);
                } else if (wave < 6) {
                    const int th = wave - 4;
                    f32x16 y0, y1;
                    { const LAS bf16* yl = R2_YL(p) + (th * 64 + lane) * 16;
                      const v4u a0 = *(const LAS v4u*)yl, a1 = *(const LAS v4u*)(yl + 8), b0 = *(const LAS v4u*)(yl + 2048), b1 = *(const LAS v4u*)(yl + 2048 + 8);
#pragma unroll
                      for (int i = 0; i < 4; ++i) { R2_UNPK(y0, 2 * i, a0[i]); R2_UNPK(y0, 8 + 2 * i, a1[i]); R2_UNPK(y1, 2 * i, b0[i]); R2_UNPK(y1, 8 + 2 * i, b1[i]); } }
                    mm<false, false>(y0, R2_ST(p), PB, 0, R2_RL(p), PB, 32 * th, lane);
                    mm<false, false>(y1, R2_ST(p), PB, 32, R2_RL(p), PB, 32 * th, lane);
                    float sm = 0.f;
#pragma unroll
                    for (int r = 0; r < 16; ++r) sm += y0[r] + y1[r];
                    sm += __shfl_xor(sm, 32);
                    const float mean = sm * (1.f / 64.f); float sq = 0.f;
#pragma unroll
                    for (int r = 0; r < 16; ++r) { y0[r] -= mean; y1[r] -= mean; sq += y0[r] * y0[r] + y1[r] * y1[r]; }
                    sq += __shfl_xor(sq, 32);
                    const float rstd = rsqrtf(sq * (1.f / 64.f) + 64e-5f);
                    const int tl = 32 * th + l31;
                    const float bon = R2_BL(p)[tl];
                    const int tro = (4 * hh + ((lane & 15) >> 2)) * PB + (32 * th + 16 * ((lane >> 4) & 1) + 4 * (lane & 3)) * 2;
                    const LAS unsigned char* vsp = R2_VL(p) + tro; const LAS unsigned char* ggp = R2_GL(p) + tro;
                    bf16* op = mix + (size_t)(b * S + c * 64 + tl) * D + 512 + h * 64 + 4 * hh;
#pragma unroll
                    for (int half = 0; half < 2; ++half)
#pragma unroll
                        for (int rg = 0; rg < 4; ++rg) {
                            const int vo = 32 * half + 8 * rg;
                            const f32x4 lw = *(const LAS f32x4*)(LNW + vo + 4 * hh), lb = *(const LAS f32x4*)(LNB + vo + 4 * hh);
                            const v2u vv = __builtin_bit_cast(v2u, __builtin_amdgcn_ds_read_tr16_b64_v4i16((LAS v4i16_t*)(vsp + vo * PB))), gg = __builtin_bit_cast(v2u, __builtin_amdgcn_ds_read_tr16_b64_v4i16((LAS v4i16_t*)(ggp + vo * PB)));
                            const float v0 = __builtin_bit_cast(float, vv.x << 16), v1 = __builtin_bit_cast(float, vv.x & 0xffff0000u), v2 = __builtin_bit_cast(float, vv.y << 16), v3 = __builtin_bit_cast(float, vv.y & 0xffff0000u);
                            const float g0 = __builtin_bit_cast(float, gg.x << 16), g1 = __builtin_bit_cast(float, gg.x & 0xffff0000u), g2 = __builtin_bit_cast(float, gg.y << 16), g3 = __builtin_bit_cast(float, gg.y & 0xffff0000u);
                            const float e0 = half ? y1[4 * rg] : y0[4 * rg], e1 = half ? y1[4 * rg + 1] : y0[4 * rg + 1], e2 = half ? y1[4 * rg + 2] : y0[4 * rg + 2], e3 = half ? y1[4 * rg + 3] : y0[4 * rg + 3];
                            const float o0 = (e0 * rstd * lw.x + lb.x + bon * v0) * g0, o1 = (e1 * rstd * lw.y + lb.y + bon * v1) * g1, o2 = (e2 * rstd * lw.z + lb.z + bon * v2) * g2, o3 = (e3 * rstd * lw.w + lb.w + bon * v3) * g3;
                            *(uint2*)(op + vo) = make_uint2(pk2(o0, o1), pk2(o2, o3));
                        }
                }
                LBAR();
            }
#undef R2_ST
#undef R2_BUF
#undef R2_ML
#undef R2_RL
#undef R2_VL
#undef R2_GL
#undef R2_BL
#undef R2_YL
#undef R2_LOADT
#undef R2_WRITET
#undef R2_LOADACC
#undef R2_UNPK
        }
        }
        LBAR();
        typedef short bf16x8 __attribute__((ext_vector_type(8)));
        typedef short s16x4 __attribute__((ext_vector_type(4)));
        typedef float f32x16 __attribute__((ext_vector_type(16)));
        const float *qg = args.in[3], *kg = args.in[4];
        LAS unsigned char* wl = lds + RING_OFF + wave * 6400;
        LAS float* rkbuf = (LAS float*)(wl + 6144);
        const int q = lane & 31, hh = lane >> 5;
        const int pil = 16 * ((q >> 2) & 1) + (q & 3) + 4 * (q >> 3);
        const int trg = lane >> 4, tri = lane & 15;
        const unsigned troff = (unsigned)((16 * (trg >> 1) + (tri >> 2)) * 192 + 32 * (trg & 1) + 8 * (tri & 3));
        const unsigned vwoff = (unsigned)((lane >> 3) * 192 + (lane & 7) * 16);
        constexpr float SB_EPS = 1.0e-30f;
        unsigned* uq = (unsigned*)(ctl + CW_UQ);
        constexpr int WPRE = 192, WKEYS = 448, KP = 144, VP = 192, NUNIT = NB * 8 * 8;
        LAS unsigned char* KL = lds + RING_OFF; LAS unsigned char* VL = KL + WKEYS * KP;
        static_assert(WKEYS * (KP + VP) <= FREE_BYTES, "attention window in LDS");
        volatile LAS int* tick = (volatile LAS int*)(MISC + 16);
        v4u kreg[7], vreg[7];
#define ATT_ISSUE(U) do { const int qb8_ = (U) & 7, h_ = ((U) >> 3) & 7, b_ = (U) >> 6; const int q0_ = qb8_ * 256, kw0_ = (q0_ > WPRE) ? q0_ - WPRE : 0, nrow_ = q0_ + 256 - kw0_; \
            const bf16* base_ = qkv + (size_t)(b_ * S) * QKVW + h_ * 64; \
            _Pragma("unroll") for (int j = 0; j < 7; ++j) { int row_ = (tid + 512 * j) >> 3; row_ = row_ < nrow_ ? row_ : nrow_ - 1; const bf16* p_ = base_ + (size_t)(kw0_ + row_) * QKVW + 512 + (tid & 7) * 8; kreg[j] = *(const v4u*)p_; vreg[j] = *(const v4u*)(p_ + 512); } } while (0)
        const int xq = bx & 7; constexpr int UPX = NUNIT / 8;
        uq += 64 * xq;
#define ATT_TICKET() do { const unsigned t_ = atomicAdd(uq, 1u); tick[0] = (t_ < (unsigned)UPX) ? (int)(xq * UPX + t_) : NUNIT; } while (0)
        if (tid == 0) ATT_TICKET();
        LBAR();
        int un = tick[0];
        if (un < NUNIT) ATT_ISSUE(un);
        while (un < NUNIT) {
            const int qb8 = un & 7, h = (un >> 3) & 7, b = un >> 6;
            const int q0 = qb8 * 256, kw0 = (q0 > WPRE) ? q0 - WPRE : 0, nrow = q0 + 256 - kw0;
            const bf16* qbase = qkv + (size_t)(b * S) * QKVW + h * 64;
            const bf16* kbase = qbase + 512; const bf16* vbase = qbase + 1024;
            v4u qraw[4];
#pragma unroll
            for (int ks = 0; ks < 4; ++ks) qraw[ks] = *(const v4u*)(qbase + (size_t)(q0 + 32 * wave + q) * QKVW + 16 * ks + 8 * hh);
#pragma unroll
            for (int j = 0; j < 7; ++j) {
                const int row = (tid + 512 * j) >> 3, ch = tid & 7;
                float kv[8]; float ss = 0.f;
#pragma unroll
                for (int i = 0; i < 4; ++i) { kv[2 * i] = __builtin_bit_cast(float, kreg[j][i] << 16); kv[2 * i + 1] = __builtin_bit_cast(float, kreg[j][i] & 0xffff0000u); ss += kv[2 * i] * kv[2 * i] + kv[2 * i + 1] * kv[2 * i + 1]; }
                ss += __shfl_xor(ss, 1); ss += __shfl_xor(ss, 2); ss += __shfl_xor(ss, 4);
                const float rs = rsqrtf(ss * (1.f / 64.f) + 1e-6f);
                if (row < nrow) {
                    *(LAS v4u*)(KL + row * KP + ch * 16) = (v4u){pk2(kv[0] * rs, kv[1] * rs), pk2(kv[2] * rs, kv[3] * rs), pk2(kv[4] * rs, kv[5] * rs), pk2(kv[6] * rs, kv[7] * rs)};
                    *(LAS v4u*)(VL + row * VP + ch * 16) = vreg[j]; }
            }
            bf16x8 qf[4];
            {
                float qv[4][8]; float ss = 0.f;
#pragma unroll
                for (int ks = 0; ks < 4; ++ks)
#pragma unroll
                    for (int i = 0; i < 4; ++i) { qv[ks][2 * i] = __builtin_bit_cast(float, qraw[ks][i] << 16); qv[ks][2 * i + 1] = __builtin_bit_cast(float, qraw[ks][i] & 0xffff0000u); ss += qv[ks][2 * i] * qv[ks][2 * i] + qv[ks][2 * i + 1] * qv[ks][2 * i + 1]; }
                ss += __shfl_xor(ss, 32);
                const float rs = rsqrtf(ss * (1.f / 64.f) + 1e-6f) * (0.125f * 1.4426950408889634f);
#pragma unroll
                for (int ks = 0; ks < 4; ++ks) {
                    const f32x4 g0 = *(const f32x4*)(qg + 16 * ks + 8 * hh), g1 = *(const f32x4*)(qg + 16 * ks + 8 * hh + 4), k0 = *(const f32x4*)(kg + 16 * ks + 8 * hh), k1 = *(const f32x4*)(kg + 16 * ks + 8 * hh + 4);
                    v4u w; w.x = pk2(qv[ks][0] * rs * g0.x * k0.x, qv[ks][1] * rs * g0.y * k0.y); w.y = pk2(qv[ks][2] * rs * g0.z * k0.z, qv[ks][3] * rs * g0.w * k0.w);
                    w.z = pk2(qv[ks][4] * rs * g1.x * k1.x, qv[ks][5] * rs * g1.y * k1.y); w.w = pk2(qv[ks][6] * rs * g1.z * k1.z, qv[ks][7] * rs * g1.w * k1.w);
                    qf[ks] = __builtin_bit_cast(bf16x8, w); }
            }
            if (tid == 0) ATT_TICKET();
            LBAR();
            const int un_next = tick[0];
            if (un_next < NUNIT) ATT_ISSUE(un_next);
            const int t0 = q0 + 32 * wave, qb = t0 >> 5, kg_lo = kw0 >> 5;
            f32x16 oT0, oT1;
#pragma unroll
            for (int r = 0; r < 16; ++r) { oT0[r] = 0.f; oT1[r] = 0.f; }
            float carry = 1.f;
            int kgp = qb; bool done = false;
            for (; kgp >= kg_lo; --kgp) {
                const int rowbase = 32 * kgp - kw0;
                f32x16 z;
#pragma unroll
                for (int r = 0; r < 16; ++r) z[r] = 0.f;
#pragma unroll
                for (int ks = 0; ks < 4; ++ks) { const bf16x8 kfl = *(const LAS bf16x8*)(KL + (rowbase + pil) * KP + (16 * ks + 8 * hh) * 2); z = __builtin_amdgcn_mfma_f32_32x32x16_bf16(kfl, qf[ks], z, 0, 0, 0); }
                float om[16];
                const bool diag = (kgp == qb);
#pragma unroll
                for (int r = 0; r < 16; ++r) { float e = __builtin_amdgcn_exp2f(z[r]); if (diag && (16 * hh + r >= q)) e = 0.f; om[r] = __builtin_amdgcn_rcpf(1.f + e); }
                float w[16]; float p = 1.f;
#pragma unroll
                for (int r = 15; r >= 0; --r) { const float pn = p * om[r]; w[r] = p - pn; p = pn; }
                const float pother = __shfl_xor(p, 32);
                const float f = carry * (hh ? 1.f : pother);
                carry = carry * p * pother;
                bf16x8 pw[2];
#pragma unroll
                for (int s2 = 0; s2 < 2; ++s2) { v4u t; t.x = pk2(w[8 * s2] * f, w[8 * s2 + 1] * f); t.y = pk2(w[8 * s2 + 2] * f, w[8 * s2 + 3] * f); t.z = pk2(w[8 * s2 + 4] * f, w[8 * s2 + 5] * f); t.w = pk2(w[8 * s2 + 6] * f, w[8 * s2 + 7] * f);
                    pw[s2] = __builtin_bit_cast(bf16x8, t); }
                const LAS unsigned char* vt = VL + rowbase * VP + troff;
#pragma unroll
                for (int s2 = 0; s2 < 2; ++s2) {
                    const s16x4 a00 = __builtin_bit_cast(s16x4, __builtin_amdgcn_ds_read_tr16_b64_v4i16((LAS v4i16_t*)(vt + (8 * s2) * VP)));
                    const s16x4 a01 = __builtin_bit_cast(s16x4, __builtin_amdgcn_ds_read_tr16_b64_v4i16((LAS v4i16_t*)(vt + (8 * s2 + 4) * VP)));
                    const s16x4 a10 = __builtin_bit_cast(s16x4, __builtin_amdgcn_ds_read_tr16_b64_v4i16((LAS v4i16_t*)(vt + (8 * s2) * VP + 64)));
                    const s16x4 a11 = __builtin_bit_cast(s16x4, __builtin_amdgcn_ds_read_tr16_b64_v4i16((LAS v4i16_t*)(vt + (8 * s2 + 4) * VP + 64)));
                    const bf16x8 va0 = __builtin_shufflevector(a00, a01, 0, 1, 2, 3, 4, 5, 6, 7), va1 = __builtin_shufflevector(a10, a11, 0, 1, 2, 3, 4, 5, 6, 7);
                    oT0 = __builtin_amdgcn_mfma_f32_32x32x16_bf16(va0, pw[s2], oT0, 0, 0, 0);
                    oT1 = __builtin_amdgcn_mfma_f32_32x32x16_bf16(va1, pw[s2], oT1, 0, 0, 0);
                }
                if (__all(carry < SB_EPS)) { done = true; break; }
            }
            LBAR();
            if (!done && kgp >= 0) {
                bf16x8 kf[4]; v4u vr[4];
                {
                    const bf16* kp = kbase + (size_t)(32 * kgp + pil) * QKVW + 8 * hh;
#pragma unroll
                    for (int ks = 0; ks < 4; ++ks) kf[ks] = *(const bf16x8*)(kp + 16 * ks);
                    const bf16* vp = vbase + (size_t)(32 * kgp + (lane >> 3)) * QKVW + (lane & 7) * 8;
#pragma unroll
                    for (int i = 0; i < 4; ++i) vr[i] = *(const v4u*)(vp + (size_t)(8 * i) * QKVW);
                }
                for (; kgp >= 0; --kgp) {
#pragma unroll
                    for (int i = 0; i < 4; ++i) *(LAS v4u*)(wl + vwoff + i * (8 * 192)) = vr[i];
                    float ss = 0.f;
#pragma unroll
                    for (int ks = 0; ks < 4; ++ks)
#pragma unroll
                        for (int j = 0; j < 8; ++j) { const float kv = bf2f((bf16)kf[ks][j]); ss += kv * kv; }
                    ss += __shfl_xor(ss, 32);
                    rkbuf[pil] = rsqrtf(ss * (1.f / 64.f) + 1e-6f);
                    f32x16 z;
#pragma unroll
                    for (int r = 0; r < 16; ++r) z[r] = 0.f;
#pragma unroll
                    for (int ks = 0; ks < 4; ++ks) z = __builtin_amdgcn_mfma_f32_32x32x16_bf16(kf[ks], qf[ks], z, 0, 0, 0);
                    asm volatile("" ::: "memory");
                    float rk[16];
#pragma unroll
                    for (int i = 0; i < 4; ++i) { const f32x4 t4 = *(const LAS f32x4*)(rkbuf + 16 * hh + 4 * i); rk[4 * i] = t4.x; rk[4 * i + 1] = t4.y; rk[4 * i + 2] = t4.z; rk[4 * i + 3] = t4.w; }
                    if (kgp > 0) {
                        const int kb = (kgp - 1) * 32;
                        const bf16* kp = kbase + (size_t)(kb + pil) * QKVW + 8 * hh;
#pragma unroll
                        for (int ks = 0; ks < 4; ++ks) kf[ks] = *(const bf16x8*)(kp + 16 * ks);
                        const bf16* vp = vbase + (size_t)(kb + (lane >> 3)) * QKVW + (lane & 7) * 8;
#pragma unroll
                        for (int i = 0; i < 4; ++i) vr[i] = *(const v4u*)(vp + (size_t)(8 * i) * QKVW);
                    }
                    float om[16];
#pragma unroll
                    for (int r = 0; r < 16; ++r) { const float e = __builtin_amdgcn_exp2f(z[r] * rk[r]); om[r] = __builtin_amdgcn_rcpf(1.f + e); }
                    float w[16]; float p = 1.f;
#pragma unroll
                    for (int r = 15; r >= 0; --r) { const float pn = p * om[r]; w[r] = p - pn; p = pn; }
                    const float pother = __shfl_xor(p, 32);
                    const float f = carry * (hh ? 1.f : pother);
                    carry = carry * p * pother;
                    bf16x8 pw[2];
#pragma unroll
                    for (int s2 = 0; s2 < 2; ++s2) { v4u t; t.x = pk2(w[8 * s2] * f, w[8 * s2 + 1] * f); t.y = pk2(w[8 * s2 + 2] * f, w[8 * s2 + 3] * f); t.z = pk2(w[8 * s2 + 4] * f, w[8 * s2 + 5] * f); t.w = pk2(w[8 * s2 + 6] * f, w[8 * s2 + 7] * f);
                        pw[s2] = __builtin_bit_cast(bf16x8, t); }
#pragma unroll
                    for (int s2 = 0; s2 < 2; ++s2) {
                        const s16x4 a00 = __builtin_bit_cast(s16x4, __builtin_amdgcn_ds_read_tr16_b64_v4i16((LAS v4i16_t*)(wl + troff + (8 * s2) * 192)));
                        const s16x4 a01 = __builtin_bit_cast(s16x4, __builtin_amdgcn_ds_read_tr16_b64_v4i16((LAS v4i16_t*)(wl + troff + (8 * s2 + 4) * 192)));
                        const s16x4 a10 = __builtin_bit_cast(s16x4, __builtin_amdgcn_ds_read_tr16_b64_v4i16((LAS v4i16_t*)(wl + troff + (8 * s2) * 192 + 64)));
                        const s16x4 a11 = __builtin_bit_cast(s16x4, __builtin_amdgcn_ds_read_tr16_b64_v4i16((LAS v4i16_t*)(wl + troff + (8 * s2 + 4) * 192 + 64)));
                        const bf16x8 va0 = __builtin_shufflevector(a00, a01, 0, 1, 2, 3, 4, 5, 6, 7), va1 = __builtin_shufflevector(a10, a11, 0, 1, 2, 3, 4, 5, 6, 7);
                        oT0 = __builtin_amdgcn_mfma_f32_32x32x16_bf16(va0, pw[s2], oT0, 0, 0, 0);
                        oT1 = __builtin_amdgcn_mfma_f32_32x32x16_bf16(va1, pw[s2], oT1, 0, 0, 0);
                    }
                    asm volatile("" ::: "memory");
                    if (__all(carry < SB_EPS)) break;
                }
            }
            bf16* op = mix + (size_t)(b * S + t0 + q) * D + h * 64 + 4 * hh;
#pragma unroll
            for (int rg = 0; rg < 4; ++rg) {
                *(uint2*)(op + 8 * rg) = make_uint2(pk2(oT0[4 * rg], oT0[4 * rg + 1]), pk2(oT0[4 * rg + 2], oT0[4 * rg + 3]));
                *(uint2*)(op + 32 + 8 * rg) = make_uint2(pk2(oT1[4 * rg], oT1[4 * rg + 1]), pk2(oT1[4 * rg + 2], oT1[4 * rg + 3]));
            }
            LBAR();
            un = un_next;
        }
#undef ATT_ISSUE
#undef ATT_TICKET
        if (IN(3) && IN(5)) GRID_BAR();
    }

    if (IN(5)) {
        PHASE_ENTRY();
        pg8::Gemm g{mix, Wout_t, NT, D, D}; pg8::StaticOrder So; So.init(NT, D, G, bx);
        pg8::EpiRes E{xb, SSPg, rstd1};
        pg8::gemm_phase<pg8::EpiRes, pg8::StaticOrder, true, false>(lds + RING_OFF, g, So, E);
        if (BOTH(5)) GRID_BAR();
    }

    if (IN(6)) {
        PHASE_ENTRY();
        const float* g2 = args.in[17];
        {
            typedef short bf16x8 __attribute__((ext_vector_type(8)));
            constexpr int WPI = 2064, WLO = 36 * WPI;
            static_assert(2 * WLO + 256 <= FREE_BYTES, "router weights in LDS");
            LAS unsigned char* WH = lds;
            LAS int* lcount = (LAS int*)(lds + 2 * WLO); LAS int* lbase = lcount + 32; LAS float* G2l = (LAS float*)(lds + 2 * WLO + 256);
            static_assert(2 * WLO + 256 + 4096 <= FREE_BYTES, "route LDS map");
            if (tid < 32) lcount[tid] = 0;
            if (tid < 256) *(LAS f32x4*)(G2l + 4 * tid) = *(const f32x4*)(g2 + 4 * tid);
            {
                v4u wa[9], wb[9];
#pragma unroll
                for (int j = 0; j < 9; ++j) { const int q_ = tid + 512 * j; wa[j] = *(const v4u*)(WRh + (size_t)(q_ >> 7) * D + (q_ & 127) * 8); wb[j] = *(const v4u*)(WRl + (size_t)(q_ >> 7) * D + (q_ & 127) * 8); }
#pragma unroll
                for (int j = 0; j < 9; ++j) { const int q_ = tid + 512 * j; *(LAS v4u*)(WH + (q_ >> 7) * WPI + (q_ & 127) * 16) = wa[j]; *(LAS v4u*)(WH + WLO + (q_ >> 7) * WPI + (q_ & 127) * 16) = wb[j]; }
            }
            __syncthreads();
            const int tk = lane & 15, kq = lane >> 4;
            const int r2row = (32 + tk < 36) ? 32 + tk : 35;
            for (int t16 = gw; t16 < NT / 16; t16 += NGW) {
                const int tok = t16 * 16 + tk;
                const bf16* xr = xb + (size_t)tok * D + 8 * kq;
                v4u xw[20];
#pragma unroll
                for (int ks = 0; ks < 20; ++ks) xw[ks] = *(const v4u*)(xr + 32 * ks);
                float ss = 0.f;
                { const f32x4* sp = (const f32x4*)(SSPg + (size_t)tok * 16);
#pragma unroll
                  for (int j = 0; j < 4; ++j) { const f32x4 t4 = sp[j]; ss += (t4[0] + t4[1]) + (t4[2] + t4[3]); } }
                const float rstd = rsqrtf(ss * (1.f / D) + 1e-6f);
                f32x4 acc0 = {0.f, 0.f, 0.f, 0.f}, acc1 = acc0, acc2 = acc0;
                unsigned char* hp = (unsigned char*)h2 + (size_t)tok * D + 8 * kq;
                const LAS unsigned char* w0p = WH + tk * WPI + 16 * kq; const LAS unsigned char* w1p = WH + (16 + tk) * WPI + 16 * kq; const LAS unsigned char* w2p = WH + r2row * WPI + 16 * kq;
#pragma unroll
                for (int ks = 0; ks < 32; ++ks) {
                    const v4u xv_ = xw[ks < 20 ? ks : ks - 20];
                    if (ks < 12) xw[ks] = *(const v4u*)(xr + 32 * (20 + ks));
                    const f32x4 g0 = *(const LAS f32x4*)(G2l + 32 * ks + 8 * kq), g1 = *(const LAS f32x4*)(G2l + 32 * ks + 8 * kq + 4);
                    const float x0 = __builtin_bit_cast(float, xv_[0] << 16), x1f = __builtin_bit_cast(float, xv_[0] & 0xffff0000u), x2 = __builtin_bit_cast(float, xv_[1] << 16), x3 = __builtin_bit_cast(float, xv_[1] & 0xffff0000u),
                                x4 = __builtin_bit_cast(float, xv_[2] << 16), x5 = __builtin_bit_cast(float, xv_[2] & 0xffff0000u), x6 = __builtin_bit_cast(float, xv_[3] << 16), x7 = __builtin_bit_cast(float, xv_[3] & 0xffff0000u);
                    *(unsigned long long*)(hp + 32 * ks) = (unsigned long long)pg8::pk4_fp8(x0 * rstd * g0[0], x1f * rstd * g0[1], x2 * rstd * g0[2], x3 * rstd * g0[3]) | ((unsigned long long)pg8::pk4_fp8(x4 * rstd * g1[0], x5 * rstd * g1[1], x6 * rstd * g1[2], x7 * rstd * g1[3]) << 32);
                    const bf16x8 xh = __builtin_bit_cast(bf16x8, xv_);
                    const bf16x8 a0h = *(const LAS bf16x8*)(w0p + 64 * ks), a0l = *(const LAS bf16x8*)(w0p + WLO + 64 * ks), a1h = *(const LAS bf16x8*)(w1p + 64 * ks), a1l = *(const LAS bf16x8*)(w1p + WLO + 64 * ks),
                                 a2h = *(const LAS bf16x8*)(w2p + 64 * ks), a2l = *(const LAS bf16x8*)(w2p + WLO + 64 * ks);
                    acc0 = __builtin_amdgcn_mfma_f32_16x16x32_bf16(a0h, xh, acc0, 0, 0, 0); acc0 = __builtin_amdgcn_mfma_f32_16x16x32_bf16(a0l, xh, acc0, 0, 0, 0);
                    acc1 = __builtin_amdgcn_mfma_f32_16x16x32_bf16(a1h, xh, acc1, 0, 0, 0); acc1 = __builtin_amdgcn_mfma_f32_16x16x32_bf16(a1l, xh, acc1, 0, 0, 0);
                    acc2 = __builtin_amdgcn_mfma_f32_16x16x32_bf16(a2h, xh, acc2, 0, 0, 0); acc2 = __builtin_amdgcn_mfma_f32_16x16x32_bf16(a2l, xh, acc2, 0, 0, 0);
                }
                int gi_l = 0; float gm = acc2[0];
#pragma unroll
                for (int o = 1; o < 4; ++o) if (acc2[o] > gm) { gm = acc2[o]; gi_l = o; }
                float gs = 0.f;
#pragma unroll
                for (int o = 0; o < 4; ++o) gs += expf((acc2[o] - gm) * rstd);
                const int gi = __shfl(gi_l, tk); const float ggate = __shfl(1.f / gs, tk);
                const f32x4 cand = (gi < 2) ? acc0 : acc1;
                const int ob = 4 * (kq & 1);
                int i0 = ob; float m0 = cand[0];
#pragma unroll
                for (int o = 1; o < 4; ++o) if (cand[o] > m0) { m0 = cand[o]; i0 = ob + o; }
                int i1 = -1; float m1 = -3.0e38f;
#pragma unroll
                for (int o = 0; o < 4; ++o) if (ob + o != i0 && cand[o] > m1) { m1 = cand[o]; i1 = ob + o; }
                {
                    const float pm0 = __shfl_xor(m0, 16), pm1 = __shfl_xor(m1, 16); const int pi0 = __shfl_xor(i0, 16), pi1 = __shfl_xor(i1, 16);
                    const bool a_first = (m0 > pm0) || (m0 == pm0 && i0 < pi0);
                    const float b0 = a_first ? m0 : pm0; const int bi0 = a_first ? i0 : pi0;
                    const float c1 = a_first ? m1 : m0, d1 = a_first ? pm0 : pm1; const int ci1 = a_first ? i1 : i0, di1 = a_first ? pi0 : pi1;
                    const bool c_first = (c1 > d1) || (c1 == d1 && ci1 < di1);
                    m0 = b0; i0 = bi0; m1 = c_first ? c1 : d1; i1 = c_first ? ci1 : di1;
                }
                const bool owner = (kq == 2 * (gi & 1));
                int e0 = 0, e1 = 0, p0 = 0, pp1 = 0;
                if (owner) {
                    const float pr1 = expf((m1 - m0) * rstd), den = 1.f + pr1;
                    e0 = gi * 8 + i0; e1 = gi * 8 + i1;
                    p0 = __hip_atomic_fetch_add(&lcount[e0], 1, __ATOMIC_RELAXED, __HIP_MEMORY_SCOPE_WORKGROUP); pp1 = __hip_atomic_fetch_add(&lcount[e1], 1, __ATOMIC_RELAXED, __HIP_MEMORY_SCOPE_WORKGROUP);
                    toke[tok] = make_int2(e0, e1); tokg[tok] = make_float2(ggate / den, ggate * pr1 / den);
                }
                __syncthreads();
                if (tid < 32) lbase[tid] = atomicAdd(&cntg[tid * 64], lcount[tid]);
                __syncthreads();
                if (owner) { const int q0 = lbase[e0] + p0, q1 = lbase[e1] + pp1; list[e0 * CAP + q0] = tok; list[e1 * CAP + q1] = tok; tokp[tok] = make_int2(q0, q1); }
                __syncthreads();
                if (tid < 32) lcount[tid] = 0;
                __syncthreads();
            }
        }
        LAS float* scr = (LAS float*)(lds + RING_OFF + wave * 16384);
        constexpr int I_GU = (D / 64) * (512 / 32), I_DN = (512 / 64) * (D / 32);
        auto mk6 = [&](int it) { TrItem t; const int e = it / (2 * I_GU + I_DN); int r = it % (2 * I_GU + I_DN);
            if (r < 2 * I_GU) { const int up = r / I_GU; r %= I_GU; const int kb = r / 16, nb = r % 16, n0 = 32 * nb;
                t = TrItem{(up ? args.in[21] : args.in[20]) + (size_t)e * D * 512, D, 512, 64 * kb, n0, (bf16*)((unsigned char*)Wgu_t + ((size_t)e * 1024 + (n0 / 128) * 256 + up * 128 + (n0 % 128)) * D), nullptr, WGU_SCALE}; }
            else { r -= 2 * I_GU; const int kb = r / 32, nb = r % 32, n0 = 32 * nb;
                t = TrItem{args.in[22] + (size_t)e * 512 * D, 512, D, 64 * kb, n0, (bf16*)((unsigned char*)Wd_t + ((size_t)e * 1024 + n0) * 512), nullptr, WD_SCALE}; }
            return t; };
        P0_TR_LOOP(gw, NGW, NE * (2 * I_GU + I_DN), scr, mk6);
        if (BOTH(6)) GRID_BAR();
    }

    LAS int* tstart = (LAS int*)(lds + TAB_OFF); LAS int* lcnt = tstart + 40;
    LAS unsigned* rowoff = (LAS unsigned*)(lds + ROWOFF_OFF);
#define BUILD_TABLES() do { __syncthreads(); if (tid < 64) { const int c_ = (tid < NE) ? cntg[tid * 64] : 0; const int nt_ = (c_ + 255) / 256; int sc_ = nt_; \
        _Pragma("unroll") for (int o_ = 1; o_ < 32; o_ <<= 1) { const int v_ = __shfl_up(sc_, o_); if ((tid & 63) >= o_) sc_ += v_; }       \
        if (tid < NE) { lcnt[tid] = c_; tstart[tid] = sc_ - nt_; if (tid == NE - 1) tstart[NE] = sc_; } } __syncthreads(); } while (0)

    if (IN(7)) {
        PHASE_ENTRY();
        BUILD_TABLES();
        pg8::MoeOrder Mo{tstart, rowoff, G, (G % 8 == 0) ? (bx % 8) * (G / 8) + bx / 8 : bx, 4};
        {   int tokv[MAXU];
#pragma unroll
            for (int i = 0; i < MAXU; ++i) { pg8::Unit u; tokv[i] = -1; if (Mo.next(i, u) && tid < 256) { const int e = u.pn >> 2, pos = (u.pm - tstart[e]) * 256 + tid; tokv[i] = (pos < lcnt[e]) ? list[e * CAP + pos] : 0; } }
#pragma unroll
            for (int i = 0; i < MAXU; ++i) if (tokv[i] >= 0) rowoff[i * 256 + tid] = (unsigned)tokv[i] * (unsigned)D; }
        __syncthreads();
        pg8::Gemm g{h2, Wgu_t, MAXROWS, NE * 1024, D};
        pg8::EpiSwiGLU E{(unsigned char*)act, 1.f / WGU_SCALE, ACT_SCALE};
        pg8::gemm_phase<pg8::EpiSwiGLU, pg8::MoeOrder, true, true, true>(lds + RING_OFF, g, Mo, E);
        if (BOTH(7)) GRID_BAR();
    }

    if (IN(8)) {
        PHASE_ENTRY();
        BUILD_TABLES();
        pg8::MoeOrder Mo{tstart, rowoff, G, (G % 8 == 0) ? (bx % 8) * (G / 8) + bx / 8 : bx, 4};
        pg8::Gemm g{act, Wd_t, MAXROWS, NE * 1024, 512};
        pg8::EpiDown E{(unsigned char*)oslot, OS_SCALE / (ACT_SCALE * WD_SCALE)};
        pg8::gemm_phase<pg8::EpiDown, pg8::MoeOrder, true, false, true>(lds + RING_OFF, g, Mo, E);
        if (BOTH(8)) GRID_BAR();
    }

    if (IN(9)) {
        PHASE_ENTRY();
        BUILD_TABLES();
        const unsigned char* os8 = (const unsigned char*)oslot;
        int2 ne4[4], np4[4]; float2 ng4[4];
#pragma unroll
        for (int q4 = 0; q4 < 4; ++q4) { const int tok = gw + q4 * NGW; ne4[q4] = toke[tok]; np4[q4] = tokp[tok]; ng4[q4] = tokg[tok]; }
        for (int tok0 = gw; tok0 < NT; tok0 += 4 * NGW) {
            int2 e4[4], p4[4]; float2 g4[4];
#pragma unroll
            for (int q4 = 0; q4 < 4; ++q4) { e4[q4] = ne4[q4]; p4[q4] = np4[q4]; g4[q4] = ng4[q4]; }
            if (tok0 + 4 * NGW < NT) {
#pragma unroll
                for (int q4 = 0; q4 < 4; ++q4) { const int tok = tok0 + 4 * NGW + q4 * NGW; ne4[q4] = toke[tok]; np4[q4] = tokp[tok]; ng4[q4] = tokg[tok]; } }
            f32x4 xv[4][4]; v4u oa[4], ob[4];
#pragma unroll
            for (int q4 = 0; q4 < 4; ++q4) { const int tok = tok0 + q4 * NGW;
                const size_t r0 = (size_t)(tstart[e4[q4].x] * 256 + p4[q4].x) * D, r1 = (size_t)(tstart[e4[q4].y] * 256 + p4[q4].y) * D;
                oa[q4] = *(const v4u*)(os8 + r0 + lane * 16); ob[q4] = *(const v4u*)(os8 + r1 + lane * 16);
                { const v4u xa_ = *(const v4u*)(xb + (size_t)tok * D + lane * 16), xb_ = *(const v4u*)(xb + (size_t)tok * D + lane * 16 + 8);
#pragma unroll
                  for (int j = 0; j < 2; ++j) { xv[q4][j] = (f32x4){__builtin_bit_cast(float, xa_[2 * j] << 16), __builtin_bit_cast(float, xa_[2 * j] & 0xffff0000u), __builtin_bit_cast(float, xa_[2 * j + 1] << 16), __builtin_bit_cast(float, xa_[2 * j + 1] & 0xffff0000u)};
                      xv[q4][2 + j] = (f32x4){__builtin_bit_cast(float, xb_[2 * j] << 16), __builtin_bit_cast(float, xb_[2 * j] & 0xffff0000u), __builtin_bit_cast(float, xb_[2 * j + 1] << 16), __builtin_bit_cast(float, xb_[2 * j + 1] & 0xffff0000u)}; } } }
#pragma unroll
            for (int q4 = 0; q4 < 4; ++q4) { const int tok = tok0 + q4 * NGW; const float ga = g4[q4].x * (1.f / OS_SCALE), gb = g4[q4].y * (1.f / OS_SCALE);
#pragma unroll
                for (int j = 0; j < 4; ++j) { f32x4 v = xv[q4][j]; const int wa = (int)oa[q4][j], wb = (int)ob[q4][j];
                    const f32x2 a01 = __builtin_amdgcn_cvt_pk_f32_fp8(wa, false), a23 = __builtin_amdgcn_cvt_pk_f32_fp8(wa, true), b01 = __builtin_amdgcn_cvt_pk_f32_fp8(wb, false), b23 = __builtin_amdgcn_cvt_pk_f32_fp8(wb, true);
                    v.x += ga * a01.x + gb * b01.x; v.y += ga * a01.y + gb * b01.y; v.z += ga * a23.x + gb * b23.x; v.w += ga * a23.y + gb * b23.y;
                    *(f32x4*)(out + (size_t)tok * D + lane * 16 + 4 * j) = v; } }
        }
    }
#undef IN
#undef BOTH
}

extern "C" void kernel_launch(void* const* d_in, const int* in_sizes, int n_in, void* d_out, int out_size, void* d_ws, size_t ws_size, hipStream_t stream) {
    static int grid = 0;
    if (grid == 0) {
        if (n_in != 23 || in_sizes[0] != NT * D || out_size != NT * D || ws_size < WS_END) { fprintf(stderr, "kernel_launch: unexpected shapes: n_in %d, ws %zu; nothing launched\n", n_in, ws_size); grid = -1; return; }
        int dev = 0, cus = 0, per_cu = 0;
        if (hipGetDevice(&dev) != hipSuccess || hipDeviceGetAttribute(&cus, hipDeviceAttributeMultiprocessorCount, dev) != hipSuccess) { grid = -1; return; }
        if (hipFuncSetAttribute((const void*)fwd, hipFuncAttributeMaxDynamicSharedMemorySize, LDS_BYTES) != hipSuccess) { fprintf(stderr, "kernel_launch: hipFuncSetAttribute failed\n"); grid = -1; return; }
        if (hipOccupancyMaxActiveBlocksPerMultiprocessor(&per_cu, (const void*)fwd, NWAVES * 64, LDS_BYTES) != hipSuccess || per_cu < 1) fprintf(stderr, "kernel_launch: occupancy query says %d\n", per_cu);
        (void)hipGetLastError();
        grid = cus;
    }
    if (grid < 0) return;
    if (hipMemsetAsync((char*)d_ws + WS_CTL, 0, CTL_ZERO_BYTES, stream) != hipSuccess) return;
    Args a{};
    for (int i = 0; i < 23; ++i) a.in[i] = (const float*)d_in[i];
    a.out = (float*)d_out; a.ws = (unsigned char*)d_ws;
    if (N_LAUNCHES == 1) { a.ph_lo = 0; a.ph_hi = NPHASE; hipLaunchKernelGGL(fwd, dim3(grid), dim3(NWAVES * 64), LDS_BYTES, stream, a); }
    else for (int li = 0; li < NPHASE; ++li) { a.ph_lo = li; a.ph_hi = li + 1; hipLaunchKernelGGL(fwd, dim3(grid), dim3(NWAVES * 64), LDS_BYTES, stream, a); }
}
```

```cpp
#include <hip/hip_runtime.h>
#include <cstdio>
#include <cstdint>

#ifndef MK_N_LAUNCHES
#define MK_N_LAUNCHES 1
#endif

namespace pg8 {
#define PG8_LAS __attribute__((address_space(3)))
typedef unsigned short bf16_t;
typedef short bf16x8 __attribute__((ext_vector_type(8)));
typedef float f32x4 __attribute__((ext_vector_type(4)));
typedef unsigned u32x4 __attribute__((ext_vector_type(4)));
typedef int v4i_t __attribute__((ext_vector_type(4)));
typedef int v8i_t __attribute__((ext_vector_type(8)));
constexpr int BM = 256, BK = 64, HALF = 128, HTB = HALF * BK * 2  , STAGE_BYTES = 8 * HTB, NXCD = 8, WGM = 8;

__host__ __device__ __forceinline__ int lds_byte(int r, int c) { const int st = (r >> 4) * 2 + (c >> 5), rr = r & 15, cc = c & 31, ob = rr * 64 + cc * 2; return st * 1024 + (ob ^ (((ob >> 9) & 1) << 5)); }
__host__ __device__ __forceinline__ void stage_rc(int b, int& R, int& C) { const int st = b / 1024, sb = b % 1024, swz = sb ^ (((sb >> 9) & 1) << 5); R = (st >> 1) * 16 + swz / 64; C = (st & 1) * 32 + (swz % 64) / 2; }
__host__ __device__ __forceinline__ int perm32(int rho) { const int n = rho >> 4, i = rho & 15; return 8 * (i >> 2) + 4 * n + (i & 3); }

struct Unit { int pm, pn; };
struct Gemm { const bf16_t* A; const bf16_t* Bt; int M, N, K; };

struct StaticOrder {
    int nM, nN, nwg, G, c;
    __host__ __device__ void init(int M, int N, int G_, int c_) { nM = M / BM; nN = N / BM; nwg = nM * nN; G = G_; c = c_; }
    __host__ __device__ bool next(int i, Unit& u) const {
        const long L = (long)i * G + c; if (L >= nwg) return false;
        int wgid = (int)L; { const int q = nwg / NXCD, r = nwg % NXCD, xcd = wgid % NXCD, off = wgid / NXCD; wgid = (xcd < r ? xcd * (q + 1) : r * (q + 1) + (xcd - r) * q) + off; }
        const int nig = WGM * nN, gid = wgid / nig, fm = gid * WGM, gsz = (nM - fm) < WGM ? (nM - fm) : WGM;
        u.pm = fm + ((wgid % nig) % gsz); u.pn = (wgid % nig) / gsz; return true;
    }
    __device__ __forceinline__ unsigned arow(int, int) const { return 0u; }
};
struct MoeOrder {
    const PG8_LAS int* tstart;
    const PG8_LAS unsigned* rowoff;
    int G, c, ntn;
    __device__ __forceinline__ bool next(int i, Unit& u) const {
        const int L = i * G + c, total = tstart[32] * ntn; if (L >= total) return false;
        const int rt = L / ntn, pnl = L - rt * ntn; int e = 0;
#pragma unroll
        for (int j = 1; j < 32; ++j) e += (rt >= tstart[j]) ? 1 : 0;
        u.pm = rt; u.pn = e * ntn + pnl; return true;
    }
    __device__ __forceinline__ unsigned arow(int ui, int r) const { return rowoff[ui * 256 + r]; }
};

__device__ __forceinline__ unsigned pk4_fp8(float a, float b, float c, float d) { int w = 0; w = __builtin_amdgcn_cvt_pk_fp8_f32(a, b, w, false); w = __builtin_amdgcn_cvt_pk_fp8_f32(c, d, w, true); return (unsigned)w; }
__device__ __forceinline__ unsigned cvt_pk_bf16(float lo, float hi) { unsigned r; asm volatile("v_cvt_pk_bf16_f32 %0, %1, %2" : "=v"(r) : "v"(lo), "v"(hi)); return r; }

struct EpiProj {
    static constexpr bool PERM = true, AFTER_DRAIN = false;
    bf16_t* qkv; bf16_t* rw;
    __device__ __forceinline__ void operator()(const f32x4 (&acc)[2][2][4][2], const Unit& u, int wr, int wc, int fr, int fq) const {
        const int row0 = u.pm * BM + wr * 64 + fr; const int colt = u.pn * BM;
        bf16_t* base; int ldc, c0;
        if (colt < 1536) { base = qkv; ldc = 1536; c0 = colt; } else { base = rw; ldc = 1792; c0 = colt - 1536; }
        const int col0 = c0 + wc * 32 + 8 * fq;
#pragma unroll
        for (int ai = 0; ai < 2; ++ai)
#pragma unroll
            for (int m = 0; m < 4; ++m) { const int row = row0 + ai * HALF + m * 16; bf16_t* rowp = base + (size_t)row * ldc + col0;
#pragma unroll
                for (int bj = 0; bj < 2; ++bj) { const f32x4 v0 = acc[ai][bj][m][0], v1 = acc[ai][bj][m][1];
                    u32x4 w; w.x = cvt_pk_bf16(v0[0], v0[1]); w.y = cvt_pk_bf16(v0[2], v0[3]); w.z = cvt_pk_bf16(v1[0], v1[1]); w.w = cvt_pk_bf16(v1[2], v1[3]);
                    *(u32x4*)(rowp + bj * HALF) = w; } }
    }
};
struct EpiRes {
    static constexpr bool PERM = true, AFTER_DRAIN = false;
    bf16_t* xio; float* ssp; const float* inv_rstd;
    __device__ __forceinline__ void operator()(const f32x4 (&acc)[2][2][4][2], const Unit& u, int wr, int wc, int fr, int fq) const {
        const int row0 = u.pm * BM + wr * 64 + fr, col0 = u.pn * BM + wc * 32 + 8 * fq;
#pragma unroll
        for (int ai = 0; ai < 2; ++ai)
#pragma unroll
            for (int m = 0; m < 4; ++m) { const int row = row0 + ai * HALF + m * 16; bf16_t* rowp = xio + (size_t)row * 1024 + col0; float sq = 0.f; const float ir = inv_rstd[row];
#pragma unroll
                for (int bj = 0; bj < 2; ++bj) { const u32x4 rb = *(const u32x4*)(rowp + bj * HALF); float v[8];
#pragma unroll
                    for (int j = 0; j < 4; ++j) { v[2 * j] = __builtin_bit_cast(float, rb[j] << 16) * ir + acc[ai][bj][m][j >> 1][(2 * j) & 3]; v[2 * j + 1] = __builtin_bit_cast(float, rb[j] & 0xffff0000u) * ir + acc[ai][bj][m][j >> 1][(2 * j + 1) & 3]; }
#pragma unroll
                    for (int j = 0; j < 8; ++j) sq += v[j] * v[j];
                    u32x4 w; w.x = cvt_pk_bf16(v[0], v[1]); w.y = cvt_pk_bf16(v[2], v[3]); w.z = cvt_pk_bf16(v[4], v[5]); w.w = cvt_pk_bf16(v[6], v[7]);
                    *(u32x4*)(rowp + bj * HALF) = w; }
                sq += __shfl_xor(sq, 16); sq += __shfl_xor(sq, 32);
                if (fq == 0) ssp[(size_t)row * 16 + u.pn * 4 + wc] = sq; }
    }
};
struct EpiSwiGLU {
    static constexpr bool PERM = true, AFTER_DRAIN = false;
    unsigned char* act; float in_scale, out_scale;
    __device__ __forceinline__ void operator()(const f32x4 (&acc)[2][2][4][2], const Unit& u, int wr, int wc, int fr, int fq) const {
        const int row0 = u.pm * BM + wr * 64 + fr, col0 = (u.pn & 3) * HALF + wc * 32 + 8 * fq;
#pragma unroll
        for (int ai = 0; ai < 2; ++ai)
#pragma unroll
            for (int m = 0; m < 4; ++m) { unsigned char* rowp = act + (size_t)(row0 + ai * HALF + m * 16) * 512 + col0; float o[8];
#pragma unroll
                for (int n = 0; n < 2; ++n)
#pragma unroll
                    for (int j = 0; j < 4; ++j) { const float g = acc[ai][0][m][n][j] * in_scale, uu = acc[ai][1][m][n][j] * in_scale; const float v = g * uu * __builtin_amdgcn_rcpf(1.f + __expf(-g)) * out_scale; o[n * 4 + j] = fminf(fmaxf(v, -416.f), 416.f); }
                *(unsigned long long*)rowp = (unsigned long long)pk4_fp8(o[0], o[1], o[2], o[3]) | ((unsigned long long)pk4_fp8(o[4], o[5], o[6], o[7]) << 32); }
    }
};
struct EpiDown {
    static constexpr bool PERM = true, AFTER_DRAIN = false;
    unsigned char* o; float scale;
    __device__ __forceinline__ void operator()(const f32x4 (&acc)[2][2][4][2], const Unit& u, int wr, int wc, int fr, int fq) const {
        const int row0 = u.pm * BM + wr * 64 + fr, col0 = (u.pn & 3) * BM + wc * 32 + 8 * fq;
#pragma unroll
        for (int ai = 0; ai < 2; ++ai)
#pragma unroll
            for (int m = 0; m < 4; ++m) { unsigned char* rowp = o + (size_t)(row0 + ai * HALF + m * 16) * 1024 + col0;
#pragma unroll
                for (int bj = 0; bj < 2; ++bj) { float v[8];
#pragma unroll
                    for (int j = 0; j < 4; ++j) { v[j] = fminf(fmaxf(acc[ai][bj][m][0][j] * scale, -416.f), 416.f); v[4 + j] = fminf(fmaxf(acc[ai][bj][m][1][j] * scale, -416.f), 416.f); }
                    *(unsigned long long*)(rowp + bj * HALF) = (unsigned long long)pk4_fp8(v[0], v[1], v[2], v[3]) | ((unsigned long long)pk4_fp8(v[4], v[5], v[6], v[7]) << 32); } }
    }
};

template <class Epi, class Sched, bool ALIGN_EPI, bool GATHER, bool F8 = false>
__device__ __forceinline__ void gemm_phase(PG8_LAS unsigned char* lds, const Gemm g, const Sched& S, const Epi& E) {
    int tid_ = threadIdx.x; asm volatile("" : "+v"(tid_));
    const int tid = tid_, wid = __builtin_amdgcn_readfirstlane(tid >> 6), lane = tid & 63, wr = wid >> 2, wc = wid & 3, fr = lane & 15, fq = lane >> 4;
    const int K = g.K, KB = F8 ? K : 2 * K, nt = KB / 128;
    unsigned voffA[2], voffB[2]; int RA[2], CA2[2];
#pragma unroll
    for (int i = 0; i < 2; ++i) { int R, C; stage_rc(tid * 16 + i * 8192, R, C); const int Rb = Epi::PERM ? ((R & ~31) + perm32(R & 31)) : R;
        voffA[i] = (unsigned)(R * KB + C * 2); voffB[i] = (unsigned)(Rb * KB + C * 2); RA[i] = R; CA2[i] = C * 2; }
    const size_t kstep = (size_t)128;
    const size_t hstep = (size_t)HALF * KB;
    const size_t tstep = 2 * hstep;
    const size_t hA = GATHER ? 0 : hstep;
    const unsigned ldsw = (unsigned)wid * 1024u;
    const int aoffk[2] = {F8 ? lds_byte(wr * 64 + fr, fq * 16) : lds_byte(wr * 64 + fr, fq * 8), F8 ? lds_byte(wr * 64 + fr, fq * 16 + 8) : lds_byte(wr * 64 + fr, fq * 8) + 1024};
    const int boffk[2] = {F8 ? lds_byte(wc * 32 + fr, fq * 16) : lds_byte(wc * 32 + fr, fq * 8), F8 ? lds_byte(wc * 32 + fr, fq * 16 + 8) : lds_byte(wc * 32 + fr, fq * 8) + 1024};
#define PG8_SA(b, h) (((b) * 2 + (h)) * HTB)
#define PG8_SB(b, h) ((4 + (b) * 2 + (h)) * HTB)
#define PG8_STAGE(bufoff, gbase, voff) do { _Pragma("unroll") for (int _i = 0; _i < 2; ++_i) \
        __builtin_amdgcn_global_load_lds((const unsigned*)((const char*)(gbase) + (voff)[_i]), (PG8_LAS unsigned*)(lds + (bufoff) + ldsw + _i * 8192), 16, 0, 0); } while (0)
#define PG8_LD8(base, off) __builtin_shufflevector(*(const PG8_LAS v4i_t*)(lds + (base) + (off)[0]), *(const PG8_LAS v4i_t*)(lds + (base) + (off)[1]), 0, 1, 2, 3, 4, 5, 6, 7)
#define PG8_LDA(dst, b, h) do { if constexpr (F8) { _Pragma("unroll") for (int m = 0; m < 4; ++m) dst##8[m] = PG8_LD8(PG8_SA(b, h) + m * 2048, aoffk); } \
        else { _Pragma("unroll") for (int m = 0; m < 4; ++m) _Pragma("unroll") for (int k = 0; k < 2; ++k) dst[m][k] = *(const PG8_LAS bf16x8*)(lds + PG8_SA(b, h) + aoffk[k] + m * 2048); } } while (0)
#define PG8_LDB(dst, b, h) do { if constexpr (F8) { _Pragma("unroll") for (int n = 0; n < 2; ++n) dst##8[n] = PG8_LD8(PG8_SB(b, h) + n * 2048, boffk); } \
        else { _Pragma("unroll") for (int n = 0; n < 2; ++n) _Pragma("unroll") for (int k = 0; k < 2; ++k) dst[n][k] = *(const PG8_LAS bf16x8*)(lds + PG8_SB(b, h) + boffk[k] + n * 2048); } } while (0)
#define PG8_MMA(ai, bj, At, Bt) do { __builtin_amdgcn_s_setprio(1); _Pragma("unroll") for (int m = 0; m < 4; ++m) _Pragma("unroll") for (int n = 0; n < 2; ++n) { \
        if constexpr (F8) asm volatile("v_mfma_scale_f32_16x16x128_f8f6f4 %0, %1, %2, %0, %3, %3 op_sel_hi:[0,0,0]" : "+v"(acc[ai][bj][m][n]) : "v"(Bt##8[n]), "v"(At##8[m]), "v"(f8one)); \
        else { _Pragma("unroll") for (int k = 0; k < 2; ++k) acc[ai][bj][m][n] = __builtin_amdgcn_mfma_f32_16x16x32_bf16(Bt[n][k], At[m][k], acc[ai][bj][m][n], 0, 0, 0); } } __builtin_amdgcn_s_setprio(0); } while (0)
#define PG8_WAIT_V(n) asm volatile("s_waitcnt vmcnt(" #n ")" ::: "memory")
#define PG8_WAIT_L(n) asm volatile("s_waitcnt lgkmcnt(" #n ")" ::: "memory")
#define PG8_BAR __builtin_amdgcn_s_barrier()
#define PG8_SCHED __builtin_amdgcn_sched_barrier(0)
    Unit cur, nxt; int ui = 0;
    if (!S.next(0, cur)) return;
    f32x4 acc[2][2][4][2];
#pragma unroll
    for (int a = 0; a < 2; ++a)
#pragma unroll
        for (int b = 0; b < 2; ++b)
#pragma unroll
            for (int m = 0; m < 4; ++m)
#pragma unroll
                for (int n = 0; n < 2; ++n) acc[a][b][m][n] = (f32x4){0.f, 0.f, 0.f, 0.f};
    bf16x8 At[4][2], B0[2][2], B1[2][2];
    v8i_t At8[4], B08[2], B18[2];
    const int f8one = 0x7f7f7f7f;
    unsigned vc0[2], vc1[2], vn0[2], vn1[2];
#pragma unroll
    for (int i = 0; i < 2; ++i) { if constexpr (GATHER) { vc0[i] = S.arow(0, RA[i]) + CA2[i]; vc1[i] = S.arow(0, HALF + RA[i]) + CA2[i]; } else { vc0[i] = voffA[i]; vc1[i] = voffA[i]; } vn0[i] = vc0[i]; vn1[i] = vc1[i]; }
    const char* cA = GATHER ? (const char*)g.A : (const char*)g.A + (size_t)cur.pm * tstep; const char* cB = (const char*)g.Bt + (size_t)cur.pn * tstep;
    PG8_STAGE(PG8_SB(0, 0), cB, voffB); PG8_STAGE(PG8_SB(0, 1), cB + hstep, voffB); PG8_STAGE(PG8_SA(0, 0), cA, vc0); PG8_STAGE(PG8_SA(0, 1), cA + hA, vc1);
    if (wr == 1) PG8_BAR;
    PG8_WAIT_V(2); PG8_BAR;
    PG8_STAGE(PG8_SB(1, 0), cB + kstep, voffB); PG8_STAGE(PG8_SA(1, 0), cA + kstep, vc0); PG8_STAGE(PG8_SB(1, 1), cB + hstep + kstep, voffB);
    PG8_WAIT_V(6); PG8_BAR;
    for (;;) {
        const bool has_next = S.next(ui + 1, nxt);
        const char* nA = GATHER ? (const char*)g.A : (has_next ? (const char*)g.A + (size_t)nxt.pm * tstep : cA); const char* nB = has_next ? (const char*)g.Bt + (size_t)nxt.pn * tstep : cB;
        if constexpr (GATHER) { if (has_next) {
#pragma unroll
            for (int i = 0; i < 2; ++i) { vn0[i] = S.arow(ui + 1, RA[i]) + CA2[i]; vn1[i] = S.arow(ui + 1, HALF + RA[i]) + CA2[i]; } } }
#pragma unroll 1
        for (int t = 0; t < nt; t += 2) {
            const bool last = (t == nt - 2);
            const char* a1 = cA + (size_t)(t + 1) * kstep;
            const char* a2 = last ? nA : cA + (size_t)(t + 2) * kstep; const char* b2 = last ? nB : cB + (size_t)(t + 2) * kstep;
            const char* a3 = a2 + kstep; const char* b3 = b2 + kstep;
            unsigned vs0[2], vs1[2];
#pragma unroll
            for (int i = 0; i < 2; ++i) { vs0[i] = (GATHER && last) ? vn0[i] : vc0[i]; vs1[i] = (GATHER && last) ? vn1[i] : vc1[i]; }
            PG8_LDB(B0, 0, 0); PG8_LDB(B1, 0, 1); PG8_SCHED; PG8_LDA(At, 0, 0); PG8_STAGE(PG8_SA(1, 1), a1 + hA, vc1);
            PG8_WAIT_V(8); PG8_WAIT_L(0); PG8_BAR; PG8_MMA(0, 0, At, B0); PG8_MMA(0, 1, At, B1); PG8_BAR; PG8_SCHED;
            PG8_LDA(At, 0, 1); PG8_STAGE(PG8_SB(0, 0), b2, voffB); PG8_STAGE(PG8_SB(0, 1), b2 + hstep, voffB); PG8_STAGE(PG8_SA(0, 0), a2, vs0);
            PG8_WAIT_V(8); PG8_WAIT_L(0); PG8_BAR; PG8_MMA(1, 0, At, B0); PG8_MMA(1, 1, At, B1); PG8_BAR; PG8_SCHED;
            PG8_LDB(B0, 1, 0); PG8_LDB(B1, 1, 1); PG8_SCHED; PG8_LDA(At, 1, 0); PG8_STAGE(PG8_SA(0, 1), a2 + hA, vs1);
            PG8_WAIT_V(8); PG8_WAIT_L(0); PG8_BAR; PG8_MMA(0, 0, At, B0); PG8_MMA(0, 1, At, B1); PG8_BAR; PG8_SCHED;
            PG8_LDA(At, 1, 1); PG8_STAGE(PG8_SB(1, 0), b3, voffB); PG8_STAGE(PG8_SB(1, 1), b3 + hstep, voffB); PG8_STAGE(PG8_SA(1, 0), a3, vs0);
            PG8_WAIT_V(8); PG8_WAIT_L(0); PG8_BAR; PG8_MMA(1, 0, At, B0); PG8_MMA(1, 1, At, B1); PG8_BAR; PG8_SCHED;
        }
        if constexpr (ALIGN_EPI) { if (wr == 0) PG8_BAR; }
        if constexpr (F8) asm volatile("s_nop 15\n\ts_nop 15" ::: "memory");
        E(acc, cur, wr, wc, fr, fq);
        if (!has_next) break;
#pragma unroll
        for (int a = 0; a < 2; ++a)
#pragma unroll
            for (int b = 0; b < 2; ++b)
#pragma unroll
                for (int m = 0; m < 4; ++m)
#pragma unroll
                    for (int n = 0; n < 2; ++n) acc[a][b][m][n] = (f32x4){0.f, 0.f, 0.f, 0.f};
        cur = nxt; cA = nA; cB = nB; ++ui;
#pragma unroll
        for (int i = 0; i < 2; ++i) { vc0[i] = vn0[i]; vc1[i] = vn1[i]; }
        if constexpr (ALIGN_EPI) { if (wr == 1) PG8_BAR; }
    }
    PG8_WAIT_V(0);
    if constexpr (!ALIGN_EPI) { if (wr == 0) PG8_BAR; }
    PG8_BAR;
#undef PG8_SA
#undef PG8_SB
#undef PG8_STAGE
#undef PG8_LDA
#undef PG8_LD8
#undef PG8_LDB
#undef PG8_MMA
#undef PG8_WAIT_V
#undef PG8_WAIT_L
#undef PG8_BAR
#undef PG8_SCHED
}
}

constexpr int NWAVES = 8;
constexpr int N_LAUNCHES = MK_N_LAUNCHES;
constexpr int NPHASE = 10;
constexpr int D = 1024, NB = 16, S = 2048, NT = NB * S;
constexpr int NIN = 3232, NINP = 3328, QKVW = 1536, RWP = 1792;
constexpr int NE = 32, CAP = 32768, MAXROWS = 65536 + NE * 256, MAXU = 8;
constexpr float WGU_SCALE = 64.f, WD_SCALE = 32.f, ACT_SCALE = 8.f, OS_SCALE = 16.f;
constexpr size_t MiB = 1u << 20;
constexpr size_t WS_CTL = 0, CTL_ZERO_BYTES = 64 * 1024;
constexpr int CW_CNT = 64, CW_UQ = 3072, CW_BAR = 4096;
constexpr size_t WS_RSTD = 1 * MiB;
constexpr size_t WS_TOKE = 2 * MiB;
constexpr size_t WS_TOKP = 3 * MiB;
constexpr size_t WS_TOKG = 4 * MiB;
constexpr size_t WS_LIST = 8 * MiB;
constexpr size_t WS_WIN = 12 * MiB;
constexpr size_t WS_WOUT = 19 * MiB;
constexpr size_t WS_XB = 22 * MiB;
constexpr size_t WS_MIX = 310 * MiB;
constexpr size_t WS_QKV = 86 * MiB;
constexpr size_t WS_H2 = WS_QKV;
constexpr size_t WS_BON = 5 * MiB;
constexpr size_t WS_WLG = 6 * MiB;
constexpr size_t WS_MT = 182 * MiB, WS_RC = 214 * MiB, WS_NN = 246 * MiB, WS_Y0 = 278 * MiB, WS_VS = 374 * MiB, WS_GG = 406 * MiB;
constexpr size_t WS_WGU = 182 * MiB;
constexpr size_t WS_WD = 246 * MiB;
constexpr size_t WS_ACT = 278 * MiB;
constexpr size_t WS_OSLOT = 352 * MiB;
constexpr size_t WS_SSP = 496 * MiB;
constexpr size_t WS_WRH = 7 * MiB, WS_WRL = 7 * MiB + 128 * 1024;
constexpr size_t WS_END = 498 * MiB;
static_assert(WS_ACT + (size_t)MAXROWS * 512 * 2 <= WS_OSLOT && WS_OSLOT + (size_t)MAXROWS * 1024 * 2 <= WS_END && WS_GG + (size_t)4096 * 4096 * 2 <= WS_END, "ws map");
constexpr int RING_OFF = 0, RING_BYTES = 131072;
constexpr int LDS_BYTES = 163840;
constexpr int LDSCTL_OFF = LDS_BYTES - 1024, MISC_OFF = LDSCTL_OFF + 320;
constexpr int ROWOFF_OFF = LDSCTL_OFF - 8192;
constexpr int TAB_OFF = ROWOFF_OFF - 512;
constexpr int FREE_BYTES = TAB_OFF;
static_assert(ROWOFF_OFF + MAXU * 256 * 4 <= LDSCTL_OFF && RING_BYTES <= FREE_BYTES, "LDS map");

#define GAS __attribute__((address_space(1)))
#define LAS __attribute__((address_space(3)))
typedef unsigned short bf16;
typedef unsigned v4u __attribute__((ext_vector_type(4)));
typedef float f32x4 __attribute__((ext_vector_type(4)));
typedef float f32x2 __attribute__((ext_vector_type(2)));
typedef GAS unsigned gu32;
typedef unsigned v2u __attribute__((ext_vector_type(2)));
typedef short v4i16_t __attribute__((ext_vector_type(4)));
#define RLX_AGENT __ATOMIC_RELAXED, __HIP_MEMORY_SCOPE_AGENT
#define LDS_WAIT() asm volatile("s_waitcnt lgkmcnt(0)" ::: "memory")
#define VM_WAIT() asm volatile("s_waitcnt vmcnt(0)" ::: "memory")
__device__ __forceinline__ float bf2f(bf16 v) { return __builtin_bit_cast(float, (unsigned)v << 16); }
__device__ __forceinline__ unsigned f2bf(float f) { unsigned u = __builtin_bit_cast(unsigned, f); return (u + 0x7fffu + ((u >> 16) & 1u)) >> 16; }
typedef __bf16 bf16x2_t __attribute__((ext_vector_type(2)));
__device__ __forceinline__ unsigned pk2(float lo, float hi) { const f32x2 v = {lo, hi}; return __builtin_bit_cast(unsigned, __builtin_convertvector(v, bf16x2_t)); }
#define LBAR() do { asm volatile("s_waitcnt lgkmcnt(0)" ::: "memory"); __builtin_amdgcn_s_barrier(); asm volatile("" ::: "memory"); } while (0)
__device__ __forceinline__ float wave_sum(float v) {
#pragma unroll
    for (int o = 1; o < 64; o <<= 1) v += __shfl_xor(v, o);
    return v;
}
__device__ __forceinline__ float softplusf(float x) { return fmaxf(x, 0.f) + log1pf(expf(-fabsf(x))); }
__device__ __forceinline__ float sigmoidf(float x) { return 1.f / (1.f + expf(-x)); }

#define XB_TMO      128
#define XB_XCNT(j)  (256  + 64 * (j))
#define XB_XSUB(j)  (1280 + 64 * (j))
#define XB_XGEN(j)  (2304 + 64 * (j))
#define XB_TOP      3328
#define XB_TOPGEN   3392
#define XCD_BAR_WORDS 3456
#define XB_SPIN_CAP (1u << 18)
__device__ __forceinline__ unsigned xb_ld(unsigned* p)              { return __hip_atomic_load(p, __ATOMIC_RELAXED, __HIP_MEMORY_SCOPE_AGENT); }
__device__ __forceinline__ unsigned xb_add(unsigned* p, unsigned v) { return __hip_atomic_fetch_add(p, v, __ATOMIC_RELAXED, __HIP_MEMORY_SCOPE_AGENT); }
__device__ __forceinline__ unsigned xb_xcc_id() { return (unsigned)__builtin_amdgcn_s_getreg((3 << 11) | 20) & 0xFu; }
#define XB_SPIN(cond, bar) do { unsigned _sp = 0; while (cond) { __builtin_amdgcn_s_sleep(1); \
    if ((++_sp & 255u) == 0u) { if (xb_ld(&(bar)[XB_TMO])) break; if (_sp > XB_SPIN_CAP) { atomicAdd(&(bar)[XB_TMO], 1u); break; } } } } while (0)
struct XcdBarrier { unsigned* bar; unsigned x; volatile LAS unsigned* st; };
__device__ __forceinline__ XcdBarrier xcd_barrier_post(unsigned* bar, volatile LAS unsigned* st) {
    XcdBarrier b; b.bar = bar; b.x = xb_xcc_id(); b.st = st;
    if (threadIdx.x == 0) (void)xb_add(&bar[XB_XCNT(b.x)], 1u);
    return b;
}
__device__ __forceinline__ void xcd_barrier_complete(unsigned* bar, unsigned x, unsigned& nloc, unsigned& nx) {
    const unsigned G = gridDim.x * gridDim.y * gridDim.z;
    unsigned sum, cnt, mine, sp = 0u;
    for (;;) {
        sum = 0u; cnt = 0u; mine = 0u;
#pragma unroll
        for (unsigned j = 0; j < 16; ++j) { const unsigned c = xb_ld(&bar[XB_XCNT(j)]); sum += c; cnt += (c > 0u) ? 1u : 0u; mine = (j == x) ? c : mine; }
        if (sum == G) break;
        __builtin_amdgcn_s_sleep(1);
        if ((++sp & 255u) == 0u) { if (xb_ld(&bar[XB_TMO])) break; if (sp > XB_SPIN_CAP) { atomicAdd(&bar[XB_TMO], 1u); break; } }
    }
    nloc = mine > 0u ? mine : 1u; nx = cnt > 0u ? cnt : 1u;
}
__device__ __forceinline__ void xcd_barrier(const XcdBarrier& b) {
    asm volatile("s_waitcnt vmcnt(0)" ::: "memory");
    __syncthreads();
    if (threadIdx.x == 0) {
        unsigned* bar = b.bar;
        __builtin_amdgcn_s_waitcnt(0);
        unsigned nloc = b.st[0], nx = b.st[1];
        if (nloc == 0u) { xcd_barrier_complete(bar, b.x, nloc, nx); b.st[0] = nloc; b.st[1] = nx; }
        const unsigned old = xb_add(&bar[XB_XSUB(b.x)], 1u);
        const unsigned gen = old / nloc;
        if (old + 1u == (gen + 1u) * nloc) {
            __builtin_amdgcn_fence(__ATOMIC_RELEASE, "agent");
            asm volatile("s_waitcnt vmcnt(0)" ::: "memory");
            const unsigned og = xb_add(&bar[XB_TOP], 1u);
            const unsigned tg = og / nx;
            if (og + 1u == (tg + 1u) * nx) xb_add(&bar[XB_TOPGEN], 1u);
            else XB_SPIN(xb_ld(&bar[XB_TOPGEN]) == tg, bar);
            __builtin_amdgcn_fence(__ATOMIC_ACQUIRE, "agent");
            xb_add(&bar[XB_XGEN(b.x)], 1u);
            asm volatile("s_waitcnt vmcnt(0)" ::: "memory");
        } else {
            XB_SPIN(xb_ld(&bar[XB_XGEN(b.x)]) == gen, bar);
            __builtin_amdgcn_fence(__ATOMIC_ACQUIRE, "agent");
            asm volatile("s_waitcnt vmcnt(0)" ::: "memory");
        }
    }
    __syncthreads();
}

namespace rw {
typedef short bf16x8 __attribute__((ext_vector_type(8)));
typedef short s16x4 __attribute__((ext_vector_type(4)));
typedef float f32x16 __attribute__((ext_vector_type(16)));
constexpr int PB = 144;
__device__ __forceinline__ bf16x8 frag_row(const LAS unsigned char* tile, int pitch, int rowbase, int ks, int lane) {
    return *(const LAS bf16x8*)(tile + (rowbase + (lane & 31)) * pitch + (16 * ks + 8 * (lane >> 5)) * 2);
}
__device__ __forceinline__ bf16x8 frag_col(const LAS unsigned char* tile, int pitch, int rowbase, int ks, int lane) {
    const int g = lane >> 4, i = lane & 15;
    const LAS unsigned char* p = tile + (16 * ks + 8 * (g >> 1) + (i >> 2)) * pitch + (rowbase + 16 * (g & 1) + 4 * (i & 3)) * 2;
    const s16x4 lo = __builtin_bit_cast(s16x4, __builtin_amdgcn_ds_read_tr16_b64_v4i16((LAS v4i16_t*)p));
    const s16x4 hi = __builtin_bit_cast(s16x4, __builtin_amdgcn_ds_read_tr16_b64_v4i16((LAS v4i16_t*)(p + 4 * pitch)));
    return __builtin_shufflevector(lo, hi, 0, 1, 2, 3, 4, 5, 6, 7);
}
template <bool AROW, bool BROW, int KS0 = 0, int NKS = 4>
__device__ __forceinline__ void mm(f32x16& acc, const LAS unsigned char* tA, int pA, int rowA, const LAS unsigned char* tB, int pB, int rowB, int lane) {
#pragma unroll
    for (int ks = KS0; ks < KS0 + NKS; ++ks) {
        const bf16x8 a = AROW ? frag_row(tA, pA, rowA, ks, lane) : frag_col(tA, pA, rowA, ks, lane);
        const bf16x8 b = BROW ? frag_row(tB, pB, rowB, ks, lane) : frag_col(tB, pB, rowB, ks, lane);
        acc = __builtin_amdgcn_mfma_f32_32x32x16_bf16(a, b, acc, 0, 0, 0);
    }
}
__device__ __forceinline__ void zero(f32x16& a) {
#pragma unroll
    for (int r = 0; r < 16; ++r) a[r] = 0.f;
}
__device__ __forceinline__ void store_t(LAS unsigned char* tile, int nbase, int mbase, const f32x16& acc, int lane) {
    LAS unsigned char* p = tile + (nbase + (lane & 31)) * PB + (mbase + 4 * (lane >> 5)) * 2;
#pragma unroll
    for (int rg = 0; rg < 4; ++rg) *(LAS v2u*)(p + 16 * rg) = (v2u){pk2(acc[4 * rg], acc[4 * rg + 1]), pk2(acc[4 * rg + 2], acc[4 * rg + 3])};
}
__device__ __forceinline__ void store_t_g(bf16* tile, int nbase, int mbase, const f32x16& acc, int lane) {
    bf16* p = tile + (nbase + (lane & 31)) * 64 + (mbase + 4 * (lane >> 5));
#pragma unroll
    for (int rg = 0; rg < 4; ++rg) *(uint2*)(p + 8 * rg) = make_uint2(pk2(acc[4 * rg], acc[4 * rg + 1]), pk2(acc[4 * rg + 2], acc[4 * rg + 3]));
}
template <bool STRICT>
__device__ __forceinline__ void tril(f32x16& acc, int mbase, int nbase, int lane) {
    const int n = nbase + (lane & 31), m0 = mbase + 4 * (lane >> 5);
#pragma unroll
    for (int r = 0; r < 16; ++r) { const int m = m0 + (r & 3) + 8 * (r >> 2); const bool keep = STRICT ? (m > n) : (m >= n); acc[r] = keep ? acc[r] : 0.f; }
}
}

struct TrItem { const float* W; int K, N, k0, n0; bf16* dst; const float* kscale; float f8scale; };
__device__ __forceinline__ void p0_tr_load(float (&r)[32], const TrItem& it, int lane) {
#pragma unroll
    for (int i = 0; i < 32; ++i) { const int kk = 2 * i + (lane >> 5); r[i] = __builtin_nontemporal_load(it.W + (size_t)(it.k0 + kk) * it.N + it.n0 + (lane & 31)); }
}
__device__ __forceinline__ void p0_tr_store(const float (&r)[32], const TrItem& it, LAS float* scr, int lane) {
#pragma unroll
    for (int i = 0; i < 32; ++i) { const int kk = 2 * i + (lane >> 5); float v = r[i]; if (it.kscale) v *= it.kscale[it.k0 + kk]; scr[kk * 33 + (lane & 31)] = v; }
    LDS_WAIT(); asm volatile("" ::: "memory");
    const int c = lane & 7;
#pragma unroll
    for (int j = 0; j < 4; ++j) { const int n = (lane >> 3) + 8 * j; const LAS float* s = scr + (8 * c) * 33 + n;
        if (it.f8scale != 0.f) { const float f = it.f8scale;
            *(GAS unsigned long long*)((GAS unsigned char*)it.dst + (size_t)n * it.K + it.k0 + 8 * c) = (unsigned long long)pg8::pk4_fp8(s[0 * 33] * f, s[1 * 33] * f, s[2 * 33] * f, s[3 * 33] * f) | ((unsigned long long)pg8::pk4_fp8(s[4 * 33] * f, s[5 * 33] * f, s[6 * 33] * f, s[7 * 33] * f) << 32); }
        else { v4u o; o.x = pk2(s[0 * 33], s[1 * 33]); o.y = pk2(s[2 * 33], s[3 * 33]); o.z = pk2(s[4 * 33], s[5 * 33]); o.w = pk2(s[6 * 33], s[7 * 33]);
            *(GAS v4u*)(it.dst + (size_t)n * it.K + it.k0 + 8 * c) = o; } }
    LDS_WAIT(); asm volatile("" ::: "memory");
}
#define P0_TR_LOOP(first, stride, nitems, scr, MK) do { float ra_[32], rb_[32]; \
    for (int it_ = (first); it_ < (nitems); it_ += 2 * (stride)) { const TrItem ia_ = MK(it_); const bool hb_ = it_ + (stride) < (nitems); const TrItem ib_ = MK(hb_ ? it_ + (stride) : it_); \
        p0_tr_load(ra_, ia_, lane); if (hb_) p0_tr_load(rb_, ib_, lane); p0_tr_store(ra_, ia_, scr, lane); if (hb_) p0_tr_store(rb_, ib_, scr, lane); } } while (0)

struct Args { const float* in[23]; float* out; unsigned char* ws; int ph_lo, ph_hi; };
__global__ void __launch_bounds__(NWAVES * 64, 2) fwd(Args args) {
    extern __shared__ __attribute__((aligned(16))) unsigned char lds_raw[];
    LAS unsigned char* lds = (LAS unsigned char*)lds_raw;
    volatile LAS unsigned* MISC = (volatile LAS unsigned*)(lds + MISC_OFF);
    int tid = threadIdx.x, lane = tid & 63; const int wave = __builtin_amdgcn_readfirstlane(tid >> 6);
    const int G = gridDim.x, bx = blockIdx.x;
    const int gw = bx * NWAVES + wave, NGW = G * NWAVES;
#define PHASE_ENTRY() do { asm volatile("" : "+v"(tid)); lane = tid & 63; } while (0)
    unsigned char* ws = args.ws;
    gu32* ctl = (gu32*)(ws + WS_CTL);
    const float* x = args.in[0]; float* out = args.out;
    float* rstd1 = (float*)(ws + WS_RSTD);
    int2* toke = (int2*)(ws + WS_TOKE); int2* tokp = (int2*)(ws + WS_TOKP); float2* tokg = (float2*)(ws + WS_TOKG); int* list = (int*)(ws + WS_LIST);
    bf16* Win_t = (bf16*)(ws + WS_WIN); bf16* Wout_t = (bf16*)(ws + WS_WOUT); bf16* xb = (bf16*)(ws + WS_XB); bf16* mix = (bf16*)(ws + WS_MIX);
    bf16* qkv = (bf16*)(ws + WS_QKV); bf16* h2 = (bf16*)(ws + WS_H2); bf16* rwraw = (bf16*)out;
    bf16 *MTg = (bf16*)(ws + WS_MT), *RCg = (bf16*)(ws + WS_RC), *VSg = (bf16*)(ws + WS_VS), *GGg = (bf16*)(ws + WS_GG), *WLg = (bf16*)(ws + WS_WLG); bf16 *NNg = (bf16*)(ws + WS_NN), *Y0g = (bf16*)(ws + WS_Y0); float* BONg = (float*)(ws + WS_BON);
    bf16* Wgu_t = (bf16*)(ws + WS_WGU); bf16* Wd_t = (bf16*)(ws + WS_WD); bf16* act = (bf16*)(ws + WS_ACT); bf16* oslot = (bf16*)(ws + WS_OSLOT);
    int* cntg = (int*)(ctl + CW_CNT);
    float* SSPg = (float*)(ws + WS_SSP); bf16* WRh = (bf16*)(ws + WS_WRH); bf16* WRl = (bf16*)(ws + WS_WRL);

    for (int u = tid; u < (LDS_BYTES - LDSCTL_OFF) / 4; u += NWAVES * 64) ((LAS unsigned*)(lds + LDSCTL_OFF))[u] = 0u;
    __syncthreads();
    XcdBarrier bar; bar.bar = (unsigned*)(ctl + CW_BAR); bar.x = 0; bar.st = nullptr;
    if (N_LAUNCHES != NPHASE) bar = xcd_barrier_post((unsigned*)(ctl + CW_BAR), MISC + 8);
#define GRID_BAR() do { if (N_LAUNCHES != NPHASE) xcd_barrier(bar); } while (0)
    const int lo = args.ph_lo, hi = args.ph_hi;
#ifndef PH_MASK
#define PH_MASK 0x3ff
#endif
#define IN(k) (((PH_MASK >> (k)) & 1) && lo <= (k) && (k) < hi)
#define BOTH(k) (IN(k) && IN((k) + 1))

    if (IN(0)) {
        PHASE_ENTRY();
        LAS float* scr = (LAS float*)(lds + RING_OFF + wave * 16384);
        constexpr int I_IN = (D / 64) * (NIN / 32), I_OUT = (D / 64) * (D / 32);
        auto mk0 = [&](int it) { TrItem t;
            if (it < I_IN) { const int nblk = NIN / 32, kb = it / nblk, nb = it % nblk; t = TrItem{args.in[2], D, NIN, 64 * kb, 32 * nb, Win_t + (size_t)(32 * nb) * D, args.in[1], 0.f}; }
            else { const int r = it - I_IN, nblk = D / 32, kb = r / nblk, nb = r % nblk; t = TrItem{args.in[16], D, D, 64 * kb, 32 * nb, Wout_t + (size_t)(32 * nb) * D, nullptr, 0.f}; }
            return t; };
        P0_TR_LOOP(gw, NGW, I_IN + I_OUT, scr, mk0);
        for (int i = bx * 512 + tid; i < 8 * 64 * 160; i += G * 512) { const int hh_ = i / 10240, n = (i / 160) % 64, k = i % 160; const int col = hh_ * 64 + n;
            const float v = (k < 32) ? args.in[7][k * 512 + col] : (k < 64) ? args.in[9][(k - 32) * 512 + col] : args.in[10][(k - 64) * 512 + col]; WLg[i] = (bf16)f2bf(v); }
        for (int i = bx * 512 + tid; i < 48 * 1024; i += G * 512) { const int n = i >> 10, k = i & 1023; float w = 0.f;
            if (n < 32) w = args.in[19][k * 32 + n] * args.in[17][k]; else if (n < 36) w = args.in[18][k * 4 + (n - 32)] * args.in[17][k];
            const unsigned hb = f2bf(w); WRh[i] = (bf16)hb; WRl[i] = (bf16)f2bf(w - __builtin_bit_cast(float, hb << 16)); }
        for (int i = bx * 512 + tid; i < (NINP - NIN) * D / 8; i += G * 512) ((GAS v4u*)(Win_t + (size_t)NIN * D))[i] = (v4u){0u, 0u, 0u, 0u};
        {
            f32x4 va[4][4], vb[4][4];
#define P0_LOADROWS(V, M0) do { _Pragma("unroll") for (int q4 = 0; q4 < 4; ++q4) { const GAS f32x4* xr = (const GAS f32x4*)(x + (size_t)((M0) + q4 * NGW) * D) + 2 * lane; \
                V[q4][0] = __builtin_nontemporal_load(xr); V[q4][1] = __builtin_nontemporal_load(xr + 1); V[q4][2] = __builtin_nontemporal_load(xr + 128); V[q4][3] = __builtin_nontemporal_load(xr + 129); } } while (0)
#define P0_DOROWS(V, M0) do { _Pragma("unroll") for (int q4 = 0; q4 < 4; ++q4) { const int m = (M0) + q4 * NGW; float s = 0.f; \
                _Pragma("unroll") for (int j = 0; j < 4; ++j) s += (V[q4][j].x * V[q4][j].x + V[q4][j].y * V[q4][j].y) + (V[q4][j].z * V[q4][j].z + V[q4][j].w * V[q4][j].w); \
                s = wave_sum(s); const float rs_ = rsqrtf(s * (1.f / D) + 1e-6f); if (lane == 0) rstd1[m] = 1.f / rs_; \
                _Pragma("unroll") for (int j = 0; j < 4; ++j) V[q4][j] = V[q4][j] * rs_; \
                GAS v4u* o16 = (GAS v4u*)(xb + (size_t)m * D) + lane; \
                o16[0] = (v4u){pk2(V[q4][0].x, V[q4][0].y), pk2(V[q4][0].z, V[q4][0].w), pk2(V[q4][1].x, V[q4][1].y), pk2(V[q4][1].z, V[q4][1].w)}; \
                o16[64] = (v4u){pk2(V[q4][2].x, V[q4][2].y), pk2(V[q4][2].z, V[q4][2].w), pk2(V[q4][3].x, V[q4][3].y), pk2(V[q4][3].z, V[q4][3].w)}; } } while (0)
            static_assert(NT % (8 * 2048) == 0, "row pipeline: two steps per trip at 2048 waves");
            P0_LOADROWS(va, gw);
            for (int m0 = gw; m0 < NT; m0 += 8 * NGW) {
                P0_LOADROWS(vb, m0 + 4 * NGW);
                P0_DOROWS(va, m0);
                if (m0 + 8 * NGW < NT) P0_LOADROWS(va, m0 + 8 * NGW);
                P0_DOROWS(vb, m0 + 4 * NGW);
            }
#undef P0_LOADROWS
#undef P0_DOROWS
        }
        if (BOTH(0)) GRID_BAR();
    }

    if (IN(1)) {
        PHASE_ENTRY();
        pg8::Gemm g{xb, Win_t, NT, NINP, D}; pg8::StaticOrder So; So.init(NT, NINP, G, bx);
        pg8::EpiProj E{qkv, rwraw};
        pg8::gemm_phase<pg8::EpiProj, pg8::StaticOrder, true, false>(lds + RING_OFF, g, So, E);
        if (BOTH(1)) GRID_BAR();
    }

    if (IN(2)) {
        PHASE_ENTRY();
        using namespace rw;
        const float *mu = args.in[5], *w0 = args.in[6], *a0 = args.in[8], *k_k = args.in[11], *k_a = args.in[12], *r_k = args.in[13];
        LAS unsigned char* L = lds + RING_OFF;
        constexpr int XP = 336, LP = 272;
        LAS unsigned char* XL = L; LAS unsigned char* RAWt = L + 21504; LAS unsigned char* WLt = L + 130688; LAS unsigned char* LDt = L + 46464; LAS unsigned char* At = L + 63872; LAS unsigned char* Gt = L + 73088;
        static_assert(130688 + 21504 + 640 <= FREE_BYTES, "R1 LDS map");
        LAS unsigned char* Ac = L + 82304; LAS unsigned char* Rc = Ac + 9216; LAS unsigned char* Bc = Rc + 9216; LAS unsigned char* Kc = Bc + 9216; LAS unsigned char* Vc = Kc + 9216;
        LAS float* seg = (LAS float*)(L + 128384); LAS float* WC = (LAS float*)(L + 130432);
        LAS unsigned char* Xa = L; LAS unsigned char* Xb = L + 9216; LAS unsigned char* Tta = L + 18432; LAS unsigned char* Ttb = L + 27648; LAS unsigned char* S5 = L + 36864; LAS unsigned char* S6 = L + 46080;
        const int wq = wave & 3, qi = wq >> 1, qj = wq & 1, hh = lane >> 5, l31 = lane & 31;
        const bool quadA = wave < 4;
        const int vcu = (G % 8 == 0) ? (bx % 8) * (G / 8) + bx / 8 : bx;
        const int h = vcu & 7;
        {
            for (int i = tid; i < 1280; i += 512) { const int t = i / 20, ch = i - t * 20; *(LAS v4u*)(WLt + t * XP + ch * 16) = *(const v4u*)(WLg + ((size_t)h * 64 + t) * 160 + 8 * ch); }
        }
        LAS float* MUl = (LAS float*)(WLt + 21504);
        for (int i = tid; i < 160; i += 512) MUl[i] = mu[1536 + i];
        int l0t[3], l0c[3];
#pragma unroll
        for (int n = 0; n < 3; ++n) { const int i = tid + 512 * n; const int t = (i < 1280) ? i / 20 : 0, ch = (i < 1280) ? i - (i / 20) * 20 : 0; l0t[n] = t; l0c[n] = ch;
        }
        const int chn = h * 64 + lane, w8 = wave * 8;
        const float mur = mu[chn], muk = mu[512 + chn], muv = mu[1024 + chn];
        const float kkc = k_k[chn], kac = k_a[chn], rkc = r_k[chn];
        const float w0n = w0[h * 64 + 32 * qj + l31], a0n = a0[h * 64 + 32 * qj + l31];
        v4u pcu[3], ppu[3], praw[4]; int rwg[4], rwl[4];
#pragma unroll
        for (int n = 0; n < 4; ++n) { const int q_ = tid + 512 * n, rr = q_ / 24, rem = q_ - rr * 24; rwg[n] = (rr - 1) * RWP + (rem >> 3) * 512 + (rem & 7) * 8; rwl[n] = (q_ < 1560) ? rr * 384 + (rem >> 3) * 128 + (rem & 7) * 16 : -1; }
#define R1_PREFETCH(CI) do { const int c_ = ((CI) >> 3) & 31, b_ = (CI) >> 8; const bf16* raw_ = rwraw + (size_t)(b_ * S + c_ * 64) * RWP; \
            _Pragma("unroll") for (int n = 0; n < 3; ++n) { const bf16* cp = raw_ + (size_t)l0t[n] * RWP + 1536 + 8 * l0c[n]; pcu[n] = (v4u){0u, 0u, 0u, 0u}; ppu[n] = (v4u){0u, 0u, 0u, 0u}; \
                if (tid + 512 * n < 1280) { pcu[n] = *(const v4u*)cp; if (c_ * 64 + l0t[n] > 0) ppu[n] = *(const v4u*)(cp - RWP); } } \
            _Pragma("unroll") for (int n = 0; n < 4; ++n) { praw[n] = (v4u){0u, 0u, 0u, 0u}; if (rwl[n] >= 0 && (rwl[n] >= 384 || c_ > 0)) praw[n] = *(const v4u*)(raw_ + h * 64 + rwg[n]); } } while (0)
        LBAR();
        if (vcu < NB * 32 * 8) R1_PREFETCH(vcu);
        for (int ci = vcu; ci < NB * 32 * 8; ci += G) {
            const int c = (ci >> 3) & 31, b = ci >> 8;
            const int row0 = b * S + c * 64;
            const int cx = (b * 8 + h) * 32 + c;
#pragma unroll
            for (int n = 0; n < 4; ++n) if (rwl[n] >= 0) *(LAS v4u*)(RAWt + rwl[n]) = praw[n];
#pragma unroll
            for (int n = 0; n < 3; ++n) if (tid + 512 * n < 1280) {
                const int t = l0t[n], ch = l0c[n];
                const v4u cu = pcu[n], pu = ppu[n]; const f32x4 m0 = *(const LAS f32x4*)(MUl + 8 * ch), m1 = *(const LAS f32x4*)(MUl + 8 * ch + 4);
                float xv[8];
#pragma unroll
                for (int j = 0; j < 4; ++j) {
                    const unsigned cw = cu[j], pw = pu[j];
                    const float c0 = __builtin_bit_cast(float, cw << 16), c1 = __builtin_bit_cast(float, cw & 0xffff0000u), p0 = __builtin_bit_cast(float, pw << 16), p1 = __builtin_bit_cast(float, pw & 0xffff0000u);
                    const float ma = (j < 2) ? m0[2 * j] : m1[(2 * j) & 3], mb = (j < 2) ? m0[2 * j + 1] : m1[(2 * j + 1) & 3];
                    xv[2 * j] = c0 + (p0 - c0) * ma; xv[2 * j + 1] = c1 + (p1 - c1) * mb; }
#pragma unroll
                for (int j = 0; j < 8; ++j) { if (ch < 4) xv[j] = 1.f - 2.f * __builtin_amdgcn_rcpf(1.f + __expf(2.f * xv[j])); else if (ch >= 8) xv[j] = __builtin_amdgcn_rcpf(1.f + __expf(-xv[j])); }
                v4u o; o.x = pk2(xv[0], xv[1]); o.y = pk2(xv[2], xv[3]); o.z = pk2(xv[4], xv[5]); o.w = pk2(xv[6], xv[7]);
                *(LAS v4u*)(XL + t * XP + ch * 16) = o;
            }
            LBAR();
            {
                f32x16 u0, u1; zero(u0); zero(u1);
                const int n = 32 * qj + l31;
                if (quadA) {
                    mm<true, true, 0, 2>(u0, XL, XP, 32 * qi, WLt, XP, 32 * qj, lane);
                    mm<true, true, 2, 2>(u1, XL, XP, 32 * qi, WLt, XP, 32 * qj, lane);
#pragma unroll
                    for (int r = 0; r < 16; ++r) { u0[r] = -0.6065306597f * __builtin_amdgcn_rcpf(1.f + __expf(-(u0[r] + w0n))); u1[r] = __builtin_amdgcn_rcpf(1.f + __expf(-(u1[r] + a0n))); }
                    LAS unsigned char* p = LDt + n * LP + (32 * qi + 4 * hh) * 4;
#pragma unroll
                    for (int rg = 0; rg < 4; ++rg) *(LAS f32x4*)(p + 32 * rg) = (f32x4){u0[4 * rg], u0[4 * rg + 1], u0[4 * rg + 2], u0[4 * rg + 3]};
                    store_t(At, 32 * qj, 32 * qi, u1, lane);
                } else {
                    mm<true, true, 4, 6>(u0, XL, XP, 32 * qi, WLt, XP, 32 * qj, lane);
                    store_t(Gt, 32 * qj, 32 * qi, u0, lane);
                }
            }
            LBAR();
            {
                const int k = lane;
                const LAS unsigned char* rwp = RAWt + w8 * 384 + 2 * k;
                float pr = bf2f(*(const LAS bf16*)(rwp)), pk = bf2f(*(const LAS bf16*)(rwp + 128)), pv = bf2f(*(const LAS bf16*)(rwp + 256));
                const v4u au = *(const LAS v4u*)(At + k * PB + w8 * 2);
                const v4u gu = *(const LAS v4u*)(Gt + k * PB + w8 * 2);
                const f32x4 l0 = *(const LAS f32x4*)(LDt + k * LP + w8 * 4), l1 = *(const LAS f32x4*)(LDt + k * LP + w8 * 4 + 16);
                float av[8], ldv[8], rs[8], kp[8], na[8], bb[8], vs[8];
#pragma unroll
                for (int j = 0; j < 4; ++j) { av[2 * j] = __builtin_bit_cast(float, au[j] << 16); av[2 * j + 1] = __builtin_bit_cast(float, au[j] & 0xffff0000u); ldv[j] = l0[j]; ldv[4 + j] = l1[j]; }
                float red[16], kkv[8];
#pragma unroll
                for (int tt = 0; tt < 8; ++tt) {
                    const float cr = bf2f(*(const LAS bf16*)(rwp + (tt + 1) * 384)), ck = bf2f(*(const LAS bf16*)(rwp + (tt + 1) * 384 + 128)), cv = bf2f(*(const LAS bf16*)(rwp + (tt + 1) * 384 + 256));
                    const float r = cr + (pr - cr) * mur, kx = ck + (pk - ck) * muk, v = cv + (pv - cv) * muv; pr = cr; pk = ck; pv = cv;
                    const float kk = kx * kkc;
                    kp[tt] = kx * (1.f + (av[tt] - 1.f) * kac); kkv[tt] = kk; rs[tt] = r; vs[tt] = v;
                    red[tt] = kk * kk; red[8 + tt] = r * kp[tt] * rkc;
                }
                {
                    const bool u5 = (lane & 32) != 0, u4 = (lane & 16) != 0, u3 = (lane & 8) != 0, u2 = (lane & 4) != 0;
#define RS_STEP(v, n, up, msk) do { _Pragma("unroll") for (int i = 0; i < (n) / 2; ++i) { const float keep = (up) ? v[i + (n) / 2] : v[i]; const float send = (up) ? v[i] : v[i + (n) / 2]; v[i] = keep + __shfl_xor(send, msk); } } while (0)
                    RS_STEP(red, 16, u5, 32); RS_STEP(red, 8, u4, 16); RS_STEP(red, 4, u3, 8); RS_STEP(red, 2, u2, 4);
#undef RS_STEP
                    red[0] += __shfl_xor(red[0], 2); red[0] += __shfl_xor(red[0], 1);
                    if ((lane & 3) == 0 && lane >= 32) BONg[(size_t)cx * 64 + w8 + (lane >> 2) - 8] = red[0];
                }
#pragma unroll
                for (int tt = 0; tt < 8; ++tt) { const float ss = __shfl(red[0], 4 * tt); const float kkn = kkv[tt] * __builtin_amdgcn_rsqf(fmaxf(ss, 1e-24f)); na[tt] = -kkn; bb[tt] = kkn * av[tt]; }
                float cl[8]; float run = 0.f;
#pragma unroll
                for (int tt = 0; tt < 8; ++tt) { run += ldv[tt]; cl[tt] = run; }
                seg[wave * 64 + k] = run;
                LBAR();
                float off = 0.f, tot = 0.f;
#pragma unroll
                for (int w2 = 0; w2 < 8; ++w2) { const float sgm = seg[w2 * 64 + k]; tot += sgm; off += (w2 < wave) ? sgm : 0.f; }
                if (wave == 0) WC[k] = __expf(tot);
                float oa[8], orr[8], ob[8], ok[8];
#pragma unroll
                for (int tt = 0; tt < 8; ++tt) { const float cc = cl[tt] + off; const float wc = __expf(cc), winv = __expf(-cc), wp = __expf(cc - ldv[tt]);
                    oa[tt] = na[tt] * wp; orr[tt] = rs[tt] * wc; ob[tt] = bb[tt] * winv; ok[tt] = kp[tt] * winv; }
#define RW_PACK8(x) ((v4u){pk2(x[0], x[1]), pk2(x[2], x[3]), pk2(x[4], x[5]), pk2(x[6], x[7])})
                *(LAS v4u*)(Ac + k * PB + w8 * 2) = RW_PACK8(oa); *(LAS v4u*)(Rc + k * PB + w8 * 2) = RW_PACK8(orr); *(LAS v4u*)(Bc + k * PB + w8 * 2) = RW_PACK8(ob);
                *(LAS v4u*)(Kc + k * PB + w8 * 2) = RW_PACK8(ok); { const v4u vpk = RW_PACK8(vs); *(LAS v4u*)(Vc + k * PB + w8 * 2) = vpk;
                    *(v4u*)(VSg + (size_t)cx * 4096 + k * 64 + w8) = vpk; *(v4u*)(GGg + (size_t)cx * 4096 + k * 64 + w8) = gu; }
#undef RW_PACK8
            }
            if (ci + G < NB * 32 * 8) R1_PREFETCH(ci + G);
            LBAR();
            const int mb = 32 * qi, nb = 32 * qj;
            f32x16 acc, Tacc;
            zero(acc);
            if (quadA) { mm<false, false>(acc, Ac, PB, mb, Bc, PB, nb, lane); tril<true>(acc, mb, nb, lane); store_t(Xa, nb, mb, acc, lane); }
            else       { mm<false, false>(acc, Ac, PB, mb, Kc, PB, nb, lane); tril<true>(acc, mb, nb, lane); store_t(S5, nb, mb, acc, lane); }
            LBAR();
            zero(acc);
            if (quadA) { mm<false, true>(acc, Xa, PB, mb, Xa, PB, nb, lane); store_t(Xb, nb, mb, acc, lane); }
            else {
                mm<false, true>(acc, S5, PB, mb, Vc, PB, nb, lane); store_t(S6, nb, mb, acc, lane);
                const LAS unsigned char* p = Xa + (nb + l31) * PB + (mb + 4 * hh) * 2;
#pragma unroll
                for (int rg = 0; rg < 4; ++rg) { const v2u t2 = *(const LAS v2u*)(p + 16 * rg);
                    Tacc[4 * rg] = __builtin_bit_cast(float, t2.x << 16); Tacc[4 * rg + 1] = __builtin_bit_cast(float, t2.x & 0xffff0000u); Tacc[4 * rg + 2] = __builtin_bit_cast(float, t2.y << 16); Tacc[4 * rg + 3] = __builtin_bit_cast(float, t2.y & 0xffff0000u); }
#pragma unroll
                for (int r = 0; r < 16; ++r) { const int m = mb + 4 * hh + (r & 3) + 8 * (r >> 2); if (m == nb + l31) Tacc[r] += 1.f; }
                store_t(Tta, nb, mb, Tacc, lane);
            }
            LBAR();
#define RW_NEUMANN(XS, XD, TS, TD) do { if (quadA) { zero(acc); mm<false, true>(acc, XS, PB, mb, XS, PB, nb, lane); store_t(XD, nb, mb, acc, lane); } \
                else { mm<false, true>(Tacc, TS, PB, mb, XS, PB, nb, lane); store_t(TD, nb, mb, Tacc, lane); } LBAR(); } while (0)
            RW_NEUMANN(Xb, Xa, Tta, Ttb);
            RW_NEUMANN(Xa, Xb, Ttb, Tta);
            RW_NEUMANN(Xb, Xa, Tta, Ttb);
            RW_NEUMANN(Xa, Xb, Ttb, Tta);
#undef RW_NEUMANN
            if (quadA) { zero(acc); mm<false, false>(acc, Rc, PB, mb, Bc, PB, nb, lane); tril<false>(acc, mb, nb, lane); store_t(Xa, nb, mb, acc, lane); }
            else       { mm<false, true>(Tacc, Tta, PB, mb, Xb, PB, nb, lane); store_t(Ttb, nb, mb, Tacc, lane); }
            LBAR();
            zero(acc);
            if (quadA) { mm<false, false>(acc, Rc, PB, mb, Kc, PB, nb, lane); tril<false>(acc, mb, nb, lane); store_t(Xb, nb, mb, acc, lane); }
            else       { mm<false, true>(acc, Ttb, PB, mb, Ac, PB, nb, lane); store_t(S5, nb, mb, acc, lane); }
            LBAR();
            zero(acc);
            if (quadA) {
                mm<true, true>(acc, S5, PB, mb, Bc, PB, nb, lane);
                const float wcn = WC[nb + l31];
#pragma unroll
                for (int r = 0; r < 16; ++r) { const int m = mb + 4 * hh + (r & 3) + 8 * (r >> 2); acc[r] = (acc[r] + ((m == nb + l31) ? 1.f : 0.f)) * wcn; }
                store_t_g(MTg + (size_t)cx * 4096, nb, mb, acc, lane);
            } else { mm<false, true>(acc, Ttb, PB, mb, S6, PB, nb, lane); store_t(Tta, nb, mb, acc, lane); }
            LBAR();
            zero(acc);
            if (quadA) {
                mm<false, true>(acc, Xa, PB, mb, S5, PB, nb, lane);
                const LAS unsigned char* p = Rc + (nb + l31) * PB + (mb + 4 * hh) * 2;
#pragma unroll
                for (int rg = 0; rg < 4; ++rg) { const v2u t2 = *(const LAS v2u*)(p + 16 * rg);
                    acc[4 * rg] += __builtin_bit_cast(float, t2.x << 16); acc[4 * rg + 1] += __builtin_bit_cast(float, t2.x & 0xffff0000u); acc[4 * rg + 2] += __builtin_bit_cast(float, t2.y << 16); acc[4 * rg + 3] += __builtin_bit_cast(float, t2.y & 0xffff0000u); }
                store_t_g(RCg + (size_t)cx * 4096, nb, mb, acc, lane);
                zero(acc);
                mm<true, true>(acc, Tta, PB, mb, Bc, PB, nb, lane); mm<true, true>(acc, Vc, PB, mb, Kc, PB, nb, lane);
                const float wcn = WC[nb + l31];
                bf16* np = NNg + (size_t)cx * 4096 + ((qi * 2 + qj) * 64 + lane) * 16;
                *(v4u*)np = (v4u){pk2(acc[0] * wcn, acc[1] * wcn), pk2(acc[2] * wcn, acc[3] * wcn), pk2(acc[4] * wcn, acc[5] * wcn), pk2(acc[6] * wcn, acc[7] * wcn)};
                *(v4u*)(np + 8) = (v4u){pk2(acc[8] * wcn, acc[9] * wcn), pk2(acc[10] * wcn, acc[11] * wcn), pk2(acc[12] * wcn, acc[13] * wcn), pk2(acc[14] * wcn, acc[15] * wcn)};
            } else {
                mm<true, false>(acc, Tta, PB, mb, Xa, PB, nb, lane); mm<true, false>(acc, Vc, PB, mb, Xb, PB, nb, lane);
                bf16* yp = Y0g + (size_t)cx * 4096 + ((qi * 2 + qj) * 64 + lane) * 16;
                *(v4u*)yp = (v4u){pk2(acc[0], acc[1]), pk2(acc[2], acc[3]), pk2(acc[4], acc[5]), pk2(acc[6], acc[7])};
                *(v4u*)(yp + 8) = (v4u){pk2(acc[8], acc[9]), pk2(acc[10], acc[11]), pk2(acc[12], acc[13]), pk2(acc[14], acc[15])};
            }
            LBAR();
        }
#undef R1_PREFETCH
        if (BOTH(2)) GRID_BAR();
    }

    if (IN(3)) {
        PHASE_ENTRY();
        {
        using namespace rw;
        if (bx < NB * 8) {
            const float *ln_w = args.in[14], *ln_b = args.in[15];
            const int b = bx >> 3, h = bx & 7;
            LAS unsigned char* L = lds + RING_OFF;
            const int wq = wave & 3, qi = wq >> 1, qj = wq & 1, hh = lane >> 5, l31 = lane & 31;
            const int trow = tid >> 3, tch = tid & 7;
#define R2_ST(p) (L + (p) * 9216)
#define R2_BUF(p) (L + 18432 + (p) * 45568)
#define R2_YL(p) ((LAS bf16*)(R2_BUF(p) + 37376))
#define R2_ML(p) (R2_BUF(p))
#define R2_RL(p) (R2_BUF(p) + 9216)
#define R2_VL(p) (R2_BUF(p) + 18432)
#define R2_GL(p) (R2_BUF(p) + 27648)
#define R2_BL(p) ((LAS float*)(R2_BUF(p) + 36864))
            LAS float* LNW = (LAS float*)(L + 18432 + 2 * 45568); static_assert(18432 + 2 * 45568 + 512 <= FREE_BYTES, "R2 LDS map"); LAS float* LNB = LNW + 64;
            const size_t cx0 = (size_t)(b * 8 + h) * 32;
            for (int i = tid; i < 9216 / 16; i += 512) *(LAS v4u*)(L + i * 16) = (v4u){0u, 0u, 0u, 0u};
            if (tid < 64) { LNW[tid] = ln_w[h * 64 + tid]; LNB[tid] = ln_b[h * 64 + tid]; }
            v4u mreg, rreg, vreg, greg, breg, yreg0;
#define R2_LOADT(c_) do { const size_t o_ = (cx0 + (c_)) * 4096 + trow * 64 + tch * 8; mreg = __builtin_nontemporal_load((const v4u*)(MTg + o_)); rreg = __builtin_nontemporal_load((const v4u*)(RCg + o_)); vreg = __builtin_nontemporal_load((const v4u*)(VSg + o_)); greg = __builtin_nontemporal_load((const v4u*)(GGg + o_)); \
                yreg0 = __builtin_nontemporal_load((const v4u*)(Y0g + (cx0 + (c_)) * 4096 + tid * 8)); \
                if (tid < 16) breg = *(const v4u*)(BONg + (cx0 + (c_)) * 64 + tid * 4); } while (0)
#define R2_WRITET(p_) do { const int o_ = trow * PB + tch * 16; *(LAS v4u*)(R2_ML(p_) + o_) = mreg; *(LAS v4u*)(R2_RL(p_) + o_) = rreg; *(LAS v4u*)(R2_VL(p_) + o_) = vreg; *(LAS v4u*)(R2_GL(p_) + o_) = greg; \
                *(LAS v4u*)(R2_YL(p_) + tid * 8) = yreg0; \
                if (tid < 16) *(LAS v4u*)(R2_BL(p_) + tid * 4) = breg; } while (0)
            breg = (v4u){0u, 0u, 0u, 0u};
            R2_LOADT(0); R2_WRITET(0); R2_LOADT(1);
            v4u pn0 = (v4u){0u, 0u, 0u, 0u}, pn1 = pn0;
#define R2_LOADACC(c_) do { if (wave < 4) { const bf16* np = NNg + (cx0 + (c_)) * 4096 + ((qi * 2 + qj) * 64 + lane) * 16; pn0 = *(const v4u*)np; pn1 = *(const v4u*)(np + 8); } } while (0)
#define R2_UNPK(dst, i0, w) do { dst[i0] = __builtin_bit_cast(float, (w) << 16); dst[(i0) + 1] = __builtin_bit_cast(float, (w) & 0xffff0000u); } while (0)
            R2_LOADACC(0);
            LBAR();
            for (int c = 0; c < 32; ++c) {
                const int p = c & 1;
                if (c + 1 < 32) R2_WRITET(p ^ 1);
                if (c + 2 < 32) R2_LOADT(c + 2);
                if (wave < 4) {
                    f32x16 acc;
#pragma unroll
                    for (int i = 0; i < 4; ++i) { R2_UNPK(acc, 2 * i, pn0[i]); R2_UNPK(acc, 8 + 2 * i, pn1[i]); }
                    if (c + 1 < 32) R2_LOADACC(c + 1);
                    mm<false, true>(acc, R2_ST(p), PB, 32 * qi, R2_ML(p), PB, 32 * qj, lane);
                    store_t(R2_ST(p ^ 1), 32 * qj, 32 * qi, acc, lane);
                } else if (wave < 6) {
                    const int th = wave - 4;
                    f32x16 y0, y1;
                    { const LAS bf16* yl = R2_YL(p) + (th * 64 + lane) * 16;
                      const v4u a0 = *(const LAS v4u*)yl, a1 = *(const LAS v4u*)(yl + 8), b0 = *(const LAS v4u*)(yl + 2048), b1 = *(const LAS v4u*)(yl + 2048 + 8);
#pragma unroll
                      for (int i = 0; i < 4; ++i) { R2_UNPK(y0, 2 * i, a0[i]); R2_UNPK(y0, 8 + 2 * i, a1[i]); R2_UNPK(y1, 2 * i, b0[i]); R2_UNPK(y1, 8 + 2 * i, b1[i]); } }
                    mm<false, false>(y0, R2_ST(p), PB, 0, R2_RL(p), PB, 32 * th, lane);
                    mm<false, false>(y1, R2_ST(p), PB, 32, R2_RL(p), PB, 32 * th, lane);
                    float sm = 0.f;
#pragma unroll
                    for (int r = 0; r < 16; ++r) sm += y0[r] + y1[r];
                    sm += __shfl_xor(sm, 32);
                    const float mean = sm * (1.f / 64.f); float sq = 0.f;
#pragma unroll
                    for (int r = 0; r < 16; ++r) { y0[r] -= mean; y1[r] -= mean; sq += y0[r] * y0[r] + y1[r] * y1[r]; }
                    sq += __shfl_xor(sq, 32);
                    const float rstd = rsqrtf(sq * (1.f / 64.f) + 64e-5f);
                    const int tl = 32 * th + l31;
                    const float bon = R2_BL(p)[tl];
                    const int tro = (4 * hh + ((lane & 15) >> 2)) * PB + (32 * th + 16 * ((lane >> 4) & 1) + 4 * (lane & 3)) * 2;
                    const LAS unsigned char* vsp = R2_VL(p) + tro; const LAS unsigned char* ggp = R2_GL(p) + tro;
                    bf16* op = mix + (size_t)(b * S + c * 64 + tl) * D + 512 + h * 64 + 4 * hh;
#pragma unroll
                    for (int half = 0; half < 2; ++half)
#pragma unroll
                        for (int rg = 0; rg < 4; ++rg) {
                            const int vo = 32 * half + 8 * rg;
                            const f32x4 lw = *(const LAS f32x4*)(LNW + vo + 4 * hh), lb = *(const LAS f32x4*)(LNB + vo + 4 * hh);
                            const v2u vv = __builtin_bit_cast(v2u, __builtin_amdgcn_ds_read_tr16_b64_v4i16((LAS v4i16_t*)(vsp + vo * PB))), gg = __builtin_bit_cast(v2u, __builtin_amdgcn_ds_read_tr16_b64_v4i16((LAS v4i16_t*)(ggp + vo * PB)));
                            const float v0 = __builtin_bit_cast(float, vv.x << 16), v1 = __builtin_bit_cast(float, vv.x & 0xffff0000u), v2 = __builtin_bit_cast(float, vv.y << 16), v3 = __builtin_bit_cast(float, vv.y & 0xffff0000u);
                            const float g0 = __builtin_bit_cast(float, gg.x << 16), g1 = __builtin_bit_cast(float, gg.x & 0xffff0000u), g2 = __builtin_bit_cast(float, gg.y << 16), g3 = __builtin_bit_cast(float, gg.y & 0xffff0000u);
                            const float e0 = half ? y1[4 * rg] : y0[4 * rg], e1 = half ? y1[4 * rg + 1] : y0[4 * rg + 1], e2 = half ? y1[4 * rg + 2] : y0[4 * rg + 2], e3 = half ? y1[4 * rg + 3] : y0[4 * rg + 3];
                            const float o0 = (e0 * rstd * lw.x + lb.x + bon * v0) * g0, o1 = (e1 * rstd * lw.y + lb.y + bon * v1) * g1, o2 = (e2 * rstd * lw.z + lb.z + bon * v2) * g2, o3 = (e3 * rstd * lw.w + lb.w + bon * v3) * g3;
                            *(uint2*)(op + vo) = make_uint2(pk2(o0, o1), pk2(o2, o3));
                        }
                }
                LBAR();
            }
#undef R2_ST
#undef R2_BUF
#undef R2_ML
#undef R2_RL
#undef R2_VL
#undef R2_GL
#undef R2_BL
#undef R2_YL
#undef R2_LOADT
#undef R2_WRITET
#undef R2_LOADACC
#undef R2_UNPK
        }
        }
        LBAR();
        typedef short bf16x8 __attribute__((ext_vector_type(8)));
        typedef short s16x4 __attribute__((ext_vector_type(4)));
        typedef float f32x16 __attribute__((ext_vector_type(16)));
        const float *qg = args.in[3], *kg = args.in[4];
        LAS unsigned char* wl = lds + RING_OFF + wave * 6400;
        LAS float* rkbuf = (LAS float*)(wl + 6144);
        const int q = lane & 31, hh = lane >> 5;
        const int pil = 16 * ((q >> 2) & 1) + (q & 3) + 4 * (q >> 3);
        const int trg = lane >> 4, tri = lane & 15;
        const unsigned troff = (unsigned)((16 * (trg >> 1) + (tri >> 2)) * 192 + 32 * (trg & 1) + 8 * (tri & 3));
        const unsigned vwoff = (unsigned)((lane >> 3) * 192 + (lane & 7) * 16);
        constexpr float SB_EPS = 1.0e-30f;
        unsigned* uq = (unsigned*)(ctl + CW_UQ);
        constexpr int WPRE = 192, WKEYS = 448, KP = 144, VP = 192, NUNIT = NB * 8 * 8;
        LAS unsigned char* KL = lds + RING_OFF; LAS unsigned char* VL = KL + WKEYS * KP;
        static_assert(WKEYS * (KP + VP) <= FREE_BYTES, "attention window in LDS");
        volatile LAS int* tick = (volatile LAS int*)(MISC + 16);
        v4u kreg[7], vreg[7];
#define ATT_ISSUE(U) do { const int qb8_ = (U) & 7, h_ = ((U) >> 3) & 7, b_ = (U) >> 6; const int q0_ = qb8_ * 256, kw0_ = (q0_ > WPRE) ? q0_ - WPRE : 0, nrow_ = q0_ + 256 - kw0_; \
            const bf16* base_ = qkv + (size_t)(b_ * S) * QKVW + h_ * 64; \
            _Pragma("unroll") for (int j = 0; j < 7; ++j) { int row_ = (tid + 512 * j) >> 3; row_ = row_ < nrow_ ? row_ : nrow_ - 1; const bf16* p_ = base_ + (size_t)(kw0_ + row_) * QKVW + 512 + (tid & 7) * 8; kreg[j] = *(const v4u*)p_; vreg[j] = *(const v4u*)(p_ + 512); } } while (0)
        const int xq = bx & 7; constexpr int UPX = NUNIT / 8;
        uq += 64 * xq;
#define ATT_TICKET() do { const unsigned t_ = atomicAdd(uq, 1u); tick[0] = (t_ < (unsigned)UPX) ? (int)(xq * UPX + t_) : NUNIT; } while (0)
        if (tid == 0) ATT_TICKET();
        LBAR();
        int un = tick[0];
        if (un < NUNIT) ATT_ISSUE(un);
        while (un < NUNIT) {
            const int qb8 = un & 7, h = (un >> 3) & 7, b = un >> 6;
            const int q0 = qb8 * 256, kw0 = (q0 > WPRE) ? q0 - WPRE : 0, nrow = q0 + 256 - kw0;
            const bf16* qbase = qkv + (size_t)(b * S) * QKVW + h * 64;
            const bf16* kbase = qbase + 512; const bf16* vbase = qbase + 1024;
            v4u qraw[4];
#pragma unroll
            for (int ks = 0; ks < 4; ++ks) qraw[ks] = *(const v4u*)(qbase + (size_t)(q0 + 32 * wave + q) * QKVW + 16 * ks + 8 * hh);
#pragma unroll
            for (int j = 0; j < 7; ++j) {
                const int row = (tid + 512 * j) >> 3, ch = tid & 7;
                float kv[8]; float ss = 0.f;
#pragma unroll
                for (int i = 0; i < 4; ++i) { kv[2 * i] = __builtin_bit_cast(float, kreg[j][i] << 16); kv[2 * i + 1] = __builtin_bit_cast(float, kreg[j][i] & 0xffff0000u); ss += kv[2 * i] * kv[2 * i] + kv[2 * i + 1] * kv[2 * i + 1]; }
                ss += __shfl_xor(ss, 1); ss += __shfl_xor(ss, 2); ss += __shfl_xor(ss, 4);
                const float rs = rsqrtf(ss * (1.f / 64.f) + 1e-6f);
                if (row < nrow) {
                    *(LAS v4u*)(KL + row * KP + ch * 16) = (v4u){pk2(kv[0] * rs, kv[1] * rs), pk2(kv[2] * rs, kv[3] * rs), pk2(kv[4] * rs, kv[5] * rs), pk2(kv[6] * rs, kv[7] * rs)};
                    *(LAS v4u*)(VL + row * VP + ch * 16) = vreg[j]; }
            }
            bf16x8 qf[4];
            {
                float qv[4][8]; float ss = 0.f;
#pragma unroll
                for (int ks = 0; ks < 4; ++ks)
#pragma unroll
                    for (int i = 0; i < 4; ++i) { qv[ks][2 * i] = __builtin_bit_cast(float, qraw[ks][i] << 16); qv[ks][2 * i + 1] = __builtin_bit_cast(float, qraw[ks][i] & 0xffff0000u); ss += qv[ks][2 * i] * qv[ks][2 * i] + qv[ks][2 * i + 1] * qv[ks][2 * i + 1]; }
                ss += __shfl_xor(ss, 32);
                const float rs = rsqrtf(ss * (1.f / 64.f) + 1e-6f) * (0.125f * 1.4426950408889634f);
#pragma unroll
                for (int ks = 0; ks < 4; ++ks) {
                    const f32x4 g0 = *(const f32x4*)(qg + 16 * ks + 8 * hh), g1 = *(const f32x4*)(qg + 16 * ks + 8 * hh + 4), k0 = *(const f32x4*)(kg + 16 * ks + 8 * hh), k1 = *(const f32x4*)(kg + 16 * ks + 8 * hh + 4);
                    v4u w; w.x = pk2(qv[ks][0] * rs * g0.x * k0.x, qv[ks][1] * rs * g0.y * k0.y); w.y = pk2(qv[ks][2] * rs * g0.z * k0.z, qv[ks][3] * rs * g0.w * k0.w);
                    w.z = pk2(qv[ks][4] * rs * g1.x * k1.x, qv[ks][5] * rs * g1.y * k1.y); w.w = pk2(qv[ks][6] * rs * g1.z * k1.z, qv[ks][7] * rs * g1.w * k1.w);
                    qf[ks] = __builtin_bit_cast(bf16x8, w); }
            }
            if (tid == 0) ATT_TICKET();
            LBAR();
            const int un_next = tick[0];
            if (un_next < NUNIT) ATT_ISSUE(un_next);
            const int t0 = q0 + 32 * wave, qb = t0 >> 5, kg_lo = kw0 >> 5;
            f32x16 oT0, oT1;
#pragma unroll
            for (int r = 0; r < 16; ++r) { oT0[r] = 0.f; oT1[r] = 0.f; }
            float carry = 1.f;
            int kgp = qb; bool done = false;
            for (; kgp >= kg_lo; --kgp) {
                const int rowbase = 32 * kgp - kw0;
                f32x16 z;
#pragma unroll
                for (int r = 0; r < 16; ++r) z[r] = 0.f;
#pragma unroll
                for (int ks = 0; ks < 4; ++ks) { const bf16x8 kfl = *(const LAS bf16x8*)(KL + (rowbase + pil) * KP + (16 * ks + 8 * hh) * 2); z = __builtin_amdgcn_mfma_f32_32x32x16_bf16(kfl, qf[ks], z, 0, 0, 0); }
                float om[16];
                const bool diag = (kgp == qb);
#pragma unroll
                for (int r = 0; r < 16; ++r) { float e = __builtin_amdgcn_exp2f(z[r]); if (diag && (16 * hh + r >= q)) e = 0.f; om[r] = __builtin_amdgcn_rcpf(1.f + e); }
                float w[16]; float p = 1.f;
#pragma unroll
                for (int r = 15; r >= 0; --r) { const float pn = p * om[r]; w[r] = p - pn; p = pn; }
                const float pother = __shfl_xor(p, 32);
                const float f = carry * (hh ? 1.f : pother);
                carry = carry * p * pother;
                bf16x8 pw[2];
#pragma unroll
                for (int s2 = 0; s2 < 2; ++s2) { v4u t; t.x = pk2(w[8 * s2] * f, w[8 * s2 + 1] * f); t.y = pk2(w[8 * s2 + 2] * f, w[8 * s2 + 3] * f); t.z = pk2(w[8 * s2 + 4] * f, w[8 * s2 + 5] * f); t.w = pk2(w[8 * s2 + 6] * f, w[8 * s2 + 7] * f);
                    pw[s2] = __builtin_bit_cast(bf16x8, t); }
                const LAS unsigned char* vt = VL + rowbase * VP + troff;
#pragma unroll
                for (int s2 = 0; s2 < 2; ++s2) {
                    const s16x4 a00 = __builtin_bit_cast(s16x4, __builtin_amdgcn_ds_read_tr16_b64_v4i16((LAS v4i16_t*)(vt + (8 * s2) * VP)));
                    const s16x4 a01 = __builtin_bit_cast(s16x4, __builtin_amdgcn_ds_read_tr16_b64_v4i16((LAS v4i16_t*)(vt + (8 * s2 + 4) * VP)));
                    const s16x4 a10 = __builtin_bit_cast(s16x4, __builtin_amdgcn_ds_read_tr16_b64_v4i16((LAS v4i16_t*)(vt + (8 * s2) * VP + 64)));
                    const s16x4 a11 = __builtin_bit_cast(s16x4, __builtin_amdgcn_ds_read_tr16_b64_v4i16((LAS v4i16_t*)(vt + (8 * s2 + 4) * VP + 64)));
                    const bf16x8 va0 = __builtin_shufflevector(a00, a01, 0, 1, 2, 3, 4, 5, 6, 7), va1 = __builtin_shufflevector(a10, a11, 0, 1, 2, 3, 4, 5, 6, 7);
                    oT0 = __builtin_amdgcn_mfma_f32_32x32x16_bf16(va0, pw[s2], oT0, 0, 0, 0);
                    oT1 = __builtin_amdgcn_mfma_f32_32x32x16_bf16(va1, pw[s2], oT1, 0, 0, 0);
                }
                if (__all(carry < SB_EPS)) { done = true; break; }
            }
            LBAR();
            if (!done && kgp >= 0) {
                bf16x8 kf[4]; v4u vr[4];
                {
                    const bf16* kp = kbase + (size_t)(32 * kgp + pil) * QKVW + 8 * hh;
#pragma unroll
                    for (int ks = 0; ks < 4; ++ks) kf[ks] = *(const bf16x8*)(kp + 16 * ks);
                    const bf16* vp = vbase + (size_t)(32 * kgp + (lane >> 3)) * QKVW + (lane & 7) * 8;
#pragma unroll
                    for (int i = 0; i < 4; ++i) vr[i] = *(const v4u*)(vp + (size_t)(8 * i) * QKVW);
                }
                for (; kgp >= 0; --kgp) {
#pragma unroll
                    for (int i = 0; i < 4; ++i) *(LAS v4u*)(wl + vwoff + i * (8 * 192)) = vr[i];
                    float ss = 0.f;
#pragma unroll
                    for (int ks = 0; ks < 4; ++ks)
#pragma unroll
                        for (int j = 0; j < 8; ++j) { const float kv = bf2f((bf16)kf[ks][j]); ss += kv * kv; }
                    ss += __shfl_xor(ss, 32);
                    rkbuf[pil] = rsqrtf(ss * (1.f / 64.f) + 1e-6f);
                    f32x16 z;
#pragma unroll
                    for (int r = 0; r < 16; ++r) z[r] = 0.f;
#pragma unroll
                    for (int ks = 0; ks < 4; ++ks) z = __builtin_amdgcn_mfma_f32_32x32x16_bf16(kf[ks], qf[ks], z, 0, 0, 0);
                    asm volatile("" ::: "memory");
                    float rk[16];
#pragma unroll
                    for (int i = 0; i < 4; ++i) { const f32x4 t4 = *(const LAS f32x4*)(rkbuf + 16 * hh + 4 * i); rk[4 * i] = t4.x; rk[4 * i + 1] = t4.y; rk[4 * i + 2] = t4.z; rk[4 * i + 3] = t4.w; }
                    if (kgp > 0) {
                        const int kb = (kgp - 1) * 32;
                        const bf16* kp = kbase + (size_t)(kb + pil) * QKVW + 8 * hh;
#pragma unroll
                        for (int ks = 0; ks < 4; ++ks) kf[ks] = *(const bf16x8*)(kp + 16 * ks);
                        const bf16* vp = vbase + (size_t)(kb + (lane >> 3)) * QKVW + (lane & 7) * 8;
#pragma unroll
                        for (int i = 0; i < 4; ++i) vr[i] = *(const v4u*)(vp + (size_t)(8 * i) * QKVW);
                    }
                    float om[16];
#pragma unroll
                    for (int r = 0; r < 16; ++r) { const float e = __builtin_amdgcn_exp2f(z[r] * rk[r]); om[r] = __builtin_amdgcn_rcpf(1.f + e); }
                    float w[16]; float p = 1.f;
#pragma unroll
                    for (int r = 15; r >= 0; --r) { const float pn = p * om[r]; w[r] = p - pn; p = pn; }
                    const float pother = __shfl_xor(p, 32);
                    const float f = carry * (hh ? 1.f : pother);
                    carry = carry * p * pother;
                    bf16x8 pw[2];
#pragma unroll
                    for (int s2 = 0; s2 < 2; ++s2) { v4u t; t.x = pk2(w[8 * s2] * f, w[8 * s2 + 1] * f); t.y = pk2(w[8 * s2 + 2] * f, w[8 * s2 + 3] * f); t.z = pk2(w[8 * s2 + 4] * f, w[8 * s2 + 5] * f); t.w = pk2(w[8 * s2 + 6] * f, w[8 * s2 + 7] * f);
                        pw[s2] = __builtin_bit_cast(bf16x8, t); }
#pragma unroll
                    for (int s2 = 0; s2 < 2; ++s2) {
                        const s16x4 a00 = __builtin_bit_cast(s16x4, __builtin_amdgcn_ds_read_tr16_b64_v4i16((LAS v4i16_t*)(wl + troff + (8 * s2) * 192)));
                        const s16x4 a01 = __builtin_bit_cast(s16x4, __builtin_amdgcn_ds_read_tr16_b64_v4i16((LAS v4i16_t*)(wl + troff + (8 * s2 + 4) * 192)));
                        const s16x4 a10 = __builtin_bit_cast(s16x4, __builtin_amdgcn_ds_read_tr16_b64_v4i16((LAS v4i16_t*)(wl + troff + (8 * s2) * 192 + 64)));
                        const s16x4 a11 = __builtin_bit_cast(s16x4, __builtin_amdgcn_ds_read_tr16_b64_v4i16((LAS v4i16_t*)(wl + troff + (8 * s2 + 4) * 192 + 64)));
                        const bf16x8 va0 = __builtin_shufflevector(a00, a01, 0, 1, 2, 3, 4, 5, 6, 7), va1 = __builtin_shufflevector(a10, a11, 0, 1, 2, 3, 4, 5, 6, 7);
                        oT0 = __builtin_amdgcn_mfma_f32_32x32x16_bf16(va0, pw[s2], oT0, 0, 0, 0);
                        oT1 = __builtin_amdgcn_mfma_f32_32x32x16_bf16(va1, pw[s2], oT1, 0, 0, 0);
                    }
                    asm volatile("" ::: "memory");
                    if (__all(carry < SB_EPS)) break;
                }
            }
            bf16* op = mix + (size_t)(b * S + t0 + q) * D + h * 64 + 4 * hh;
#pragma unroll
            for (int rg = 0; rg < 4; ++rg) {
                *(uint2*)(op + 8 * rg) = make_uint2(pk2(oT0[4 * rg], oT0[4 * rg + 1]), pk2(oT0[4 * rg + 2], oT0[4 * rg + 3]));
                *(uint2*)(op + 32 + 8 * rg) = make_uint2(pk2(oT1[4 * rg], oT1[4 * rg + 1]), pk2(oT1[4 * rg + 2], oT1[4 * rg + 3]));
            }
            LBAR();
            un = un_next;
        }
#undef ATT_ISSUE
#undef ATT_TICKET
        if (IN(3) && IN(5)) GRID_BAR();
    }

    if (IN(5)) {
        PHASE_ENTRY();
        pg8::Gemm g{mix, Wout_t, NT, D, D}; pg8::StaticOrder So; So.init(NT, D, G, bx);
        pg8::EpiRes E{xb, SSPg, rstd1};
        pg8::gemm_phase<pg8::EpiRes, pg8::StaticOrder, true, false>(lds + RING_OFF, g, So, E);
        if (BOTH(5)) GRID_BAR();
    }

    if (IN(6)) {
        PHASE_ENTRY();
        const float* g2 = args.in[17];
        {
            typedef short bf16x8 __attribute__((ext_vector_type(8)));
            constexpr int WPI = 2064, WLO = 36 * WPI;
            static_assert(2 * WLO + 256 <= FREE_BYTES, "router weights in LDS");
            LAS unsigned char* WH = lds;
            LAS int* lcount = (LAS int*)(lds + 2 * WLO); LAS int* lbase = lcount + 32; LAS float* G2l = (LAS float*)(lds + 2 * WLO + 256);
            static_assert(2 * WLO + 256 + 4096 <= FREE_BYTES, "route LDS map");
            if (tid < 32) lcount[tid] = 0;
            if (tid < 256) *(LAS f32x4*)(G2l + 4 * tid) = *(const f32x4*)(g2 + 4 * tid);
            {
                v4u wa[9], wb[9];
#pragma unroll
                for (int j = 0; j < 9; ++j) { const int q_ = tid + 512 * j; wa[j] = *(const v4u*)(WRh + (size_t)(q_ >> 7) * D + (q_ & 127) * 8); wb[j] = *(const v4u*)(WRl + (size_t)(q_ >> 7) * D + (q_ & 127) * 8); }
#pragma unroll
                for (int j = 0; j < 9; ++j) { const int q_ = tid + 512 * j; *(LAS v4u*)(WH + (q_ >> 7) * WPI + (q_ & 127) * 16) = wa[j]; *(LAS v4u*)(WH + WLO + (q_ >> 7) * WPI + (q_ & 127) * 16) = wb[j]; }
            }
            __syncthreads();
            const int tk = lane & 15, kq = lane >> 4;
            const int r2row = (32 + tk < 36) ? 32 + tk : 35;
            for (int t16 = gw; t16 < NT / 16; t16 += NGW) {
                const int tok = t16 * 16 + tk;
                const bf16* xr = xb + (size_t)tok * D + 8 * kq;
                v4u xw[20];
#pragma unroll
                for (int ks = 0; ks < 20; ++ks) xw[ks] = *(const v4u*)(xr + 32 * ks);
                float ss = 0.f;
                { const f32x4* sp = (const f32x4*)(SSPg + (size_t)tok * 16);
#pragma unroll
                  for (int j = 0; j < 4; ++j) { const f32x4 t4 = sp[j]; ss += (t4[0] + t4[1]) + (t4[2] + t4[3]); } }
                const float rstd = rsqrtf(ss * (1.f / D) + 1e-6f);
                f32x4 acc0 = {0.f, 0.f, 0.f, 0.f}, acc1 = acc0, acc2 = acc0;
                unsigned char* hp = (unsigned char*)h2 + (size_t)tok * D + 8 * kq;
                const LAS unsigned char* w0p = WH + tk * WPI + 16 * kq; const LAS unsigned char* w1p = WH + (16 + tk) * WPI + 16 * kq; const LAS unsigned char* w2p = WH + r2row * WPI + 16 * kq;
#pragma unroll
                for (int ks = 0; ks < 32; ++ks) {
                    const v4u xv_ = xw[ks < 20 ? ks : ks - 20];
                    if (ks < 12) xw[ks] = *(const v4u*)(xr + 32 * (20 + ks));
                    const f32x4 g0 = *(const LAS f32x4*)(G2l + 32 * ks + 8 * kq), g1 = *(const LAS f32x4*)(G2l + 32 * ks + 8 * kq + 4);
                    const float x0 = __builtin_bit_cast(float, xv_[0] << 16), x1f = __builtin_bit_cast(float, xv_[0] & 0xffff0000u), x2 = __builtin_bit_cast(float, xv_[1] << 16), x3 = __builtin_bit_cast(float, xv_[1] & 0xffff0000u),
                                x4 = __builtin_bit_cast(float, xv_[2] << 16), x5 = __builtin_bit_cast(float, xv_[2] & 0xffff0000u), x6 = __builtin_bit_cast(float, xv_[3] << 16), x7 = __builtin_bit_cast(float, xv_[3] & 0xffff0000u);
                    *(unsigned long long*)(hp + 32 * ks) = (unsigned long long)pg8::pk4_fp8(x0 * rstd * g0[0], x1f * rstd * g0[1], x2 * rstd * g0[2], x3 * rstd * g0[3]) | ((unsigned long long)pg8::pk4_fp8(x4 * rstd * g1[0], x5 * rstd * g1[1], x6 * rstd * g1[2], x7 * rstd * g1[3]) << 32);
                    const bf16x8 xh = __builtin_bit_cast(bf16x8, xv_);
                    const bf16x8 a0h = *(const LAS bf16x8*)(w0p + 64 * ks), a0l = *(const LAS bf16x8*)(w0p + WLO + 64 * ks), a1h = *(const LAS bf16x8*)(w1p + 64 * ks), a1l = *(const LAS bf16x8*)(w1p + WLO + 64 * ks),
                                 a2h = *(const LAS bf16x8*)(w2p + 64 * ks), a2l = *(const LAS bf16x8*)(w2p + WLO + 64 * ks);
                    acc0 = __builtin_amdgcn_mfma_f32_16x16x32_bf16(a0h, xh, acc0, 0, 0, 0); acc0 = __builtin_amdgcn_mfma_f32_16x16x32_bf16(a0l, xh, acc0, 0, 0, 0);
                    acc1 = __builtin_amdgcn_mfma_f32_16x16x32_bf16(a1h, xh, acc1, 0, 0, 0); acc1 = __builtin_amdgcn_mfma_f32_16x16x32_bf16(a1l, xh, acc1, 0, 0, 0);
                    acc2 = __builtin_amdgcn_mfma_f32_16x16x32_bf16(a2h, xh, acc2, 0, 0, 0); acc2 = __builtin_amdgcn_mfma_f32_16x16x32_bf16(a2l, xh, acc2, 0, 0, 0);
                }
                int gi_l = 0; float gm = acc2[0];
#pragma unroll
                for (int o = 1; o < 4; ++o) if (acc2[o] > gm) { gm = acc2[o]; gi_l = o; }
                float gs = 0.f;
#pragma unroll
                for (int o = 0; o < 4; ++o) gs += expf((acc2[o] - gm) * rstd);
                const int gi = __shfl(gi_l, tk); const float ggate = __shfl(1.f / gs, tk);
                const f32x4 cand = (gi < 2) ? acc0 : acc1;
                const int ob = 4 * (kq & 1);
                int i0 = ob; float m0 = cand[0];
#pragma unroll
                for (int o = 1; o < 4; ++o) if (cand[o] > m0) { m0 = cand[o]; i0 = ob + o; }
                int i1 = -1; float m1 = -3.0e38f;
#pragma unroll
                for (int o = 0; o < 4; ++o) if (ob + o != i0 && cand[o] > m1) { m1 = cand[o]; i1 = ob + o; }
                {
                    const float pm0 = __shfl_xor(m0, 16), pm1 = __shfl_xor(m1, 16); const int pi0 = __shfl_xor(i0, 16), pi1 = __shfl_xor(i1, 16);
                    const bool a_first = (m0 > pm0) || (m0 == pm0 && i0 < pi0);
                    const float b0 = a_first ? m0 : pm0; const int bi0 = a_first ? i0 : pi0;
                    const float c1 = a_first ? m1 : m0, d1 = a_first ? pm0 : pm1; const int ci1 = a_first ? i1 : i0, di1 = a_first ? pi0 : pi1;
                    const bool c_first = (c1 > d1) || (c1 == d1 && ci1 < di1);
                    m0 = b0; i0 = bi0; m1 = c_first ? c1 : d1; i1 = c_first ? ci1 : di1;
                }
                const bool owner = (kq == 2 * (gi & 1));
                int e0 = 0, e1 = 0, p0 = 0, pp1 = 0;
                if (owner) {
                    const float pr1 = expf((m1 - m0) * rstd), den = 1.f + pr1;
                    e0 = gi * 8 + i0; e1 = gi * 8 + i1;
                    p0 = __hip_atomic_fetch_add(&lcount[e0], 1, __ATOMIC_RELAXED, __HIP_MEMORY_SCOPE_WORKGROUP); pp1 = __hip_atomic_fetch_add(&lcount[e1], 1, __ATOMIC_RELAXED, __HIP_MEMORY_SCOPE_WORKGROUP);
                    toke[tok] = make_int2(e0, e1); tokg[tok] = make_float2(ggate / den, ggate * pr1 / den);
                }
                __syncthreads();
                if (tid < 32) lbase[tid] = atomicAdd(&cntg[tid * 64], lcount[tid]);
                __syncthreads();
                if (owner) { const int q0 = lbase[e0] + p0, q1 = lbase[e1] + pp1; list[e0 * CAP + q0] = tok; list[e1 * CAP + q1] = tok; tokp[tok] = make_int2(q0, q1); }
                __syncthreads();
                if (tid < 32) lcount[tid] = 0;
                __syncthreads();
            }
        }
        LAS float* scr = (LAS float*)(lds + RING_OFF + wave * 16384);
        constexpr int I_GU = (D / 64) * (512 / 32), I_DN = (512 / 64) * (D / 32);
        auto mk6 = [&](int it) { TrItem t; const int e = it / (2 * I_GU + I_DN); int r = it % (2 * I_GU + I_DN);
            if (r < 2 * I_GU) { const int up = r / I_GU; r %= I_GU; const int kb = r / 16, nb = r % 16, n0 = 32 * nb;
                t = TrItem{(up ? args.in[21] : args.in[20]) + (size_t)e * D * 512, D, 512, 64 * kb, n0, (bf16*)((unsigned char*)Wgu_t + ((size_t)e * 1024 + (n0 / 128) * 256 + up * 128 + (n0 % 128)) * D), nullptr, WGU_SCALE}; }
            else { r -= 2 * I_GU; const int kb = r / 32, nb = r % 32, n0 = 32 * nb;
                t = TrItem{args.in[22] + (size_t)e * 512 * D, 512, D, 64 * kb, n0, (bf16*)((unsigned char*)Wd_t + ((size_t)e * 1024 + n0) * 512), nullptr, WD_SCALE}; }
            return t; };
        P0_TR_LOOP(gw, NGW, NE * (2 * I_GU + I_DN), scr, mk6);
        if (BOTH(6)) GRID_BAR();
    }

    LAS int* tstart = (LAS int*)(lds + TAB_OFF); LAS int* lcnt = tstart + 40;
    LAS unsigned* rowoff = (LAS unsigned*)(lds + ROWOFF_OFF);
#define BUILD_TABLES() do { __syncthreads(); if (tid < 64) { const int c_ = (tid < NE) ? cntg[tid * 64] : 0; const int nt_ = (c_ + 255) / 256; int sc_ = nt_; \
        _Pragma("unroll") for (int o_ = 1; o_ < 32; o_ <<= 1) { const int v_ = __shfl_up(sc_, o_); if ((tid & 63) >= o_) sc_ += v_; }       \
        if (tid < NE) { lcnt[tid] = c_; tstart[tid] = sc_ - nt_; if (tid == NE - 1) tstart[NE] = sc_; } } __syncthreads(); } while (0)

    if (IN(7)) {
        PHASE_ENTRY();
        BUILD_TABLES();
        pg8::MoeOrder Mo{tstart, rowoff, G, (G % 8 == 0) ? (bx % 8) * (G / 8) + bx / 8 : bx, 4};
        {   int tokv[MAXU];
#pragma unroll
            for (int i = 0; i < MAXU; ++i) { pg8::Unit u; tokv[i] = -1; if (Mo.next(i, u) && tid < 256) { const int e = u.pn >> 2, pos = (u.pm - tstart[e]) * 256 + tid; tokv[i] = (pos < lcnt[e]) ? list[e * CAP + pos] : 0; } }
#pragma unroll
            for (int i = 0; i < MAXU; ++i) if (tokv[i] >= 0) rowoff[i * 256 + tid] = (unsigned)tokv[i] * (unsigned)D; }
        __syncthreads();
        pg8::Gemm g{h2, Wgu_t, MAXROWS, NE * 1024, D};
        pg8::EpiSwiGLU E{(unsigned char*)act, 1.f / WGU_SCALE, ACT_SCALE};
        pg8::gemm_phase<pg8::EpiSwiGLU, pg8::MoeOrder, true, true, true>(lds + RING_OFF, g, Mo, E);
        if (BOTH(7)) GRID_BAR();
    }

    if (IN(8)) {
        PHASE_ENTRY();
        BUILD_TABLES();
        pg8::MoeOrder Mo{tstart, rowoff, G, (G % 8 == 0) ? (bx % 8) * (G / 8) + bx / 8 : bx, 4};
        pg8::Gemm g{act, Wd_t, MAXROWS, NE * 1024, 512};
        pg8::EpiDown E{(unsigned char*)oslot, OS_SCALE / (ACT_SCALE * WD_SCALE)};
        pg8::gemm_phase<pg8::EpiDown, pg8::MoeOrder, true, false, true>(lds + RING_OFF, g, Mo, E);
        if (BOTH(8)) GRID_BAR();
    }

    if (IN(9)) {
        PHASE_ENTRY();
        BUILD_TABLES();
        const unsigned char* os8 = (const unsigned char*)oslot;
        int2 ne4[4], np4[4]; float2 ng4[4];
#pragma unroll
        for (int q4 = 0; q4 < 4; ++q4) { const int tok = gw + q4 * NGW; ne4[q4] = toke[tok]; np4[q4] = tokp[tok]; ng4[q4] = tokg[tok]; }
        for (int tok0 = gw; tok0 < NT; tok0 += 4 * NGW) {
            int2 e4[4], p4[4]; float2 g4[4];
#pragma unroll
            for (int q4 = 0; q4 < 4; ++q4) { e4[q4] = ne4[q4]; p4[q4] = np4[q4]; g4[q4] = ng4[q4]; }
            if (tok0 + 4 * NGW < NT) {
#pragma unroll
                for (int q4 = 0; q4 < 4; ++q4) { const int tok = tok0 + 4 * NGW + q4 * NGW; ne4[q4] = toke[tok]; np4[q4] = tokp[tok]; ng4[q4] = tokg[tok]; } }
            f32x4 xv[4][4]; v4u oa[4], ob[4];
#pragma unroll
            for (int q4 = 0; q4 < 4; ++q4) { const int tok = tok0 + q4 * NGW;
                const size_t r0 = (size_t)(tstart[e4[q4].x] * 256 + p4[q4].x) * D, r1 = (size_t)(tstart[e4[q4].y] * 256 + p4[q4].y) * D;
                oa[q4] = __builtin_nontemporal_load((const v4u*)(os8 + r0 + lane * 16)); ob[q4] = __builtin_nontemporal_load((const v4u*)(os8 + r1 + lane * 16));
                { const v4u xa_ = __builtin_nontemporal_load((const v4u*)(xb + (size_t)tok * D + lane * 16)), xb_ = __builtin_nontemporal_load((const v4u*)(xb + (size_t)tok * D + lane * 16 + 8));
#pragma unroll
                  for (int j = 0; j < 2; ++j) { xv[q4][j] = (f32x4){__builtin_bit_cast(float, xa_[2 * j] << 16), __builtin_bit_cast(float, xa_[2 * j] & 0xffff0000u), __builtin_bit_cast(float, xa_[2 * j + 1] << 16), __builtin_bit_cast(float, xa_[2 * j + 1] & 0xffff0000u)};
                      xv[q4][2 + j] = (f32x4){__builtin_bit_cast(float, xb_[2 * j] << 16), __builtin_bit_cast(float, xb_[2 * j] & 0xffff0000u), __builtin_bit_cast(float, xb_[2 * j + 1] << 16), __builtin_bit_cast(float, xb_[2 * j + 1] & 0xffff0000u)}; } } }
#pragma unroll
            for (int q4 = 0; q4 < 4; ++q4) { const int tok = tok0 + q4 * NGW; const float ga = g4[q4].x * (1.f / OS_SCALE), gb = g4[q4].y * (1.f / OS_SCALE);
#pragma unroll
                for (int j = 0; j < 4; ++j) { f32x4 v = xv[q4][j]; const int wa = (int)oa[q4][j], wb = (int)ob[q4][j];
                    const f32x2 a01 = __builtin_amdgcn_cvt_pk_f32_fp8(wa, false), a23 = __builtin_amdgcn_cvt_pk_f32_fp8(wa, true), b01 = __builtin_amdgcn_cvt_pk_f32_fp8(wb, false), b23 = __builtin_amdgcn_cvt_pk_f32_fp8(wb, true);
                    v.x += ga * a01.x + gb * b01.x; v.y += ga * a01.y + gb * b01.y; v.z += ga * a23.x + gb * b23.x; v.w += ga * a23.y + gb * b23.y;
                    *(f32x4*)(out + (size_t)tok * D + lane * 16 + 4 * j) = v; } }
        }
    }
#undef IN
#undef BOTH
}

extern "C" void kernel_launch(void* const* d_in, const int* in_sizes, int n_in, void* d_out, int out_size, void* d_ws, size_t ws_size, hipStream_t stream) {
    static int grid = 0;
    if (grid == 0) {
        if (n_in != 23 || in_sizes[0] != NT * D || out_size != NT * D || ws_size < WS_END) { fprintf(stderr, "kernel_launch: unexpected shapes: n_in %d, ws %zu; nothing launched\n", n_in, ws_size); grid = -1; return; }
        int dev = 0, cus = 0, per_cu = 0;
        if (hipGetDevice(&dev) != hipSuccess || hipDeviceGetAttribute(&cus, hipDeviceAttributeMultiprocessorCount, dev) != hipSuccess) { grid = -1; return; }
        if (hipFuncSetAttribute((const void*)fwd, hipFuncAttributeMaxDynamicSharedMemorySize, LDS_BYTES) != hipSuccess) { fprintf(stderr, "kernel_launch: hipFuncSetAttribute failed\n"); grid = -1; return; }
        if (hipOccupancyMaxActiveBlocksPerMultiprocessor(&per_cu, (const void*)fwd, NWAVES * 64, LDS_BYTES) != hipSuccess || per_cu < 1) fprintf(stderr, "kernel_launch: occupancy query says %d\n", per_cu);
        (void)hipGetLastError();
        grid = cus;
    }
    if (grid < 0) return;
    if (hipMemsetAsync((char*)d_ws + WS_CTL, 0, CTL_ZERO_BYTES, stream) != hipSuccess) return;
    Args a{};
    for (int i = 0; i < 23; ++i) a.in[i] = (const float*)d_in[i];
    a.out = (float*)d_out; a.ws = (unsigned char*)d_ws;
    if (N_LAUNCHES == 1) { a.ph_lo = 0; a.ph_hi = NPHASE; hipLaunchKernelGGL(fwd, dim3(grid), dim3(NWAVES * 64), LDS_BYTES, stream, a); }
    else for (int li = 0; li < NPHASE; ++li) { a.ph_lo = li; a.ph_hi = li + 1; hipLaunchKernelGGL(fwd, dim3(grid), dim3(NWAVES * 64), LDS_BYTES, stream, a); }
}
```
